# Optimizing an MI355X kernel written in HIP

```python
import math
import jax, jax.numpy as jnp
from jax import lax
import numpy as np

D_MODEL = 1024
BATCH = 8
SEQ = 2048
DEPTH = 2
DEC_BATCH = 128
DEC_SEQ = 1
PAST_LEN = 16384
PAGE_SIZE = 128

N_AB = (DEPTH + 1) // 2
N_CD = DEPTH // 2
HALF = D_MODEL // 2
D_FF = 4 * D_MODEL
CHUNK = 64
CONV_W = 4
EPS = 1e-6
DT_MIN = 1e-3
DT_MAX = 1e-1
GLA_HEADS = 4
GLA_DV = HALF // GLA_HEADS
GLA_DK = GLA_DV // 2
GLA_GATE_RANK = 16
GLA_GATE_NORM = 16.0
S5_H = 16
S5_GROUPS = HALF // S5_H
S5_P = 64
SSD_HEADDIM = 64
SSD_HEADS = HALF // SSD_HEADDIM
SSD_GROUPS = 2
SSD_DSTATE = 128
SSD_CONV_DIM = HALF + 2 * SSD_GROUPS * SSD_DSTATE
GDN_HEADS = 4
GDN_DK = HALF // GDN_HEADS
GDN_DV = HALF // GDN_HEADS
GDN_CONV_DIM = 2 * GDN_HEADS * GDN_DK + GDN_HEADS * GDN_DV

IN_AB = 2 * GLA_HEADS * GLA_DK + HALF + GLA_GATE_RANK + HALF + HALF
IN_CD = HALF + SSD_CONV_DIM + SSD_HEADS + GDN_CONV_DIM + GDN_HEADS * GDN_DV + 2 * GDN_HEADS
STATE_KEYS = ('gla', 's5_re', 's5_im', 'ssd', 'ssd_conv', 'gdn', 'gdn_conv')

kernel_name = 'hybrid_gla_s5_ssd_gdn_step'


def _rmsnorm(x, g):
    x32 = x.astype(jnp.float32)
    y = x32 * lax.rsqrt(jnp.mean(x32 * x32, axis=-1, keepdims=True) + EPS)
    return (y * g.astype(jnp.float32)).astype(x.dtype)


def _l2norm(x):
    return x * lax.rsqrt(jnp.sum(x * x, axis=-1, keepdims=True) + EPS)


def _split(a, sizes):
    out, o = [], 0
    for s in sizes:
        out.append(a[..., o:o + s])
        o += s
    return out


def _to_chunks(a, c):
    L = a.shape[1]
    n = -(-L // c)
    a = jnp.pad(a, [(0, 0), (0, n * c - L)] + [(0, 0)] * (a.ndim - 2))
    a = a.reshape((a.shape[0], n, c) + a.shape[2:])
    return jnp.moveaxis(a, 1, 0)


def _from_chunks(a, L):
    a = jnp.moveaxis(a, 0, 1)
    a = a.reshape((a.shape[0], a.shape[1] * a.shape[2]) + a.shape[3:])
    return a[:, :L]


def _seg_decay(cum, strict):
    c = cum.shape[1]
    idx = jnp.arange(c)
    mask = (idx[:, None] > idx[None, :]) if strict else (idx[:, None] >= idx[None, :])
    mask = mask.reshape((1, c, c) + (1,) * (cum.ndim - 2))
    diff = cum[:, :, None] - cum[:, None, :]
    return jnp.exp(jnp.where(mask, diff, -jnp.inf))


def _causal_conv(x, buf, w):
    L = x.shape[1]
    xe = jnp.concatenate([buf.astype(x.dtype), x], axis=1)
    out = xe[:, 0:L] * w[0]
    for t in range(1, CONV_W):
        out = out + xe[:, t:t + L] * w[t]
    return out, xe[:, L:]


def _gla_scan(q, k, v, log_a, s0):
    f32 = jnp.float32
    L = q.shape[1]
    c = min(CHUNK, L)
    xs = tuple(_to_chunks(t.astype(f32), c) for t in (q, k, v, log_a))

    def step(S, inp):
        qc, kc, vc, lac = inp
        cum = jnp.cumsum(lac, axis=1)
        dec = _seg_decay(cum, False)
        att = jnp.einsum('bihk,bjhk,bijhk->bhij', qc, kc, dec)
        o = jnp.einsum('bhij,bjhv->bihv', att, vc) + jnp.einsum('bihk,bhkv->bihv', qc * jnp.exp(cum), S)
        last = cum[:, -1]
        kd = kc * jnp.exp(last[:, None] - cum)
        S = jnp.exp(last)[..., None] * S + jnp.einsum('bjhk,bjhv->bhkv', kd, vc)
        return S, o

    S, o = lax.scan(step, s0.astype(f32), xs)
    return _from_chunks(o, L), S


def _s5_scan(u, h0_re, h0_im, lam_re, lam_im, b_re, b_im, c_re, c_im, d, log_dt):
    f32 = jnp.float32
    u = u.astype(f32)
    lr, li = lam_re.astype(f32), lam_im.astype(f32)
    b_re, b_im, c_re, c_im = (t.astype(f32) for t in (b_re, b_im, c_re, c_im))
    dt = jnp.exp(log_dt.astype(f32))[:, None]
    mag = jnp.exp(lr * dt)
    ang = li * dt
    a_re, a_im = mag * jnp.cos(ang), mag * jnp.sin(ang)
    den = lr * lr + li * li
    n_re, n_im = a_re - 1.0, a_im
    k_re = (n_re * lr + n_im * li) / den
    k_im = (n_im * lr - n_re * li) / den
    bb_re = k_re[..., None] * b_re - k_im[..., None] * b_im
    bb_im = k_re[..., None] * b_im + k_im[..., None] * b_re
    bu_re = jnp.einsum('blgh,gph->blgp', u, bb_re)
    bu_im = jnp.einsum('blgh,gph->blgp', u, bb_im)
    h0_re, h0_im = h0_re.astype(f32), h0_im.astype(f32)
    bu_re = bu_re.at[:, 0].add(a_re * h0_re - a_im * h0_im)
    bu_im = bu_im.at[:, 0].add(a_re * h0_im + a_im * h0_re)
    L = u.shape[1]
    ar = jnp.broadcast_to(a_re, (1, L) + a_re.shape)
    ai = jnp.broadcast_to(a_im, (1, L) + a_im.shape)

    def combine(e1, e2):
        a1r, a1i, b1r, b1i = e1
        a2r, a2i, b2r, b2i = e2
        return (a2r * a1r - a2i * a1i, a2r * a1i + a2i * a1r,
                a2r * b1r - a2i * b1i + b2r, a2r * b1i + a2i * b1r + b2i)

    _, _, h_re, h_im = lax.associative_scan(combine, (ar, ai, bu_re, bu_im), axis=1)
    y = (jnp.einsum('blgp,ghp->blgh', h_re, c_re) - jnp.einsum('blgp,ghp->blgh', h_im, c_im)
         + d.astype(f32) * u)
    return y, h_re[:, -1], h_im[:, -1]


def _ssd_scan(xdt, la, bm, cm, s0):
    f32 = jnp.float32
    L = xdt.shape[1]
    c = min(CHUNK, L)
    xs = tuple(_to_chunks(t.astype(f32), c) for t in (xdt, la, bm, cm))

    def step(S, inp):
        xc, lac, bc, cc = inp
        cum = jnp.cumsum(lac, axis=1)
        dec = _seg_decay(cum, False)
        cb = jnp.einsum('bign,bjgn->bijg', cc, bc)
        y = jnp.einsum('bijg,bijgr,bjgrp->bigrp', cb, dec, xc)
        y = y + jnp.einsum('bign,bgrpn->bigrp', cc, S) * jnp.exp(cum)[..., None]
        last = cum[:, -1]
        w = jnp.exp(last[:, None] - cum)
        S = jnp.exp(last)[..., None, None] * S + jnp.einsum('bjgr,bjgrp,bjgn->bgrpn', w, xc, bc)
        return S, y

    S, y = lax.scan(step, s0.astype(f32), xs)
    return _from_chunks(y, L), S


def _gdn_scan(q, k, v, beta, g, s0):
    f32 = jnp.float32
    L = q.shape[1]
    c = min(CHUNK, L)
    xs = tuple(_to_chunks(t.astype(f32), c) for t in (q, k, v, beta, g))

    def step(S, inp):
        qc, kc, vc, bc, gc = inp
        cum = jnp.cumsum(gc, axis=1)
        dec_incl = _seg_decay(cum, False)
        dec_strict = _seg_decay(cum, True)
        gam = jnp.exp(cum)
        m = jnp.einsum('bihk,bjhk,bijh->bhij', kc, kc, dec_strict) * jnp.swapaxes(bc, 1, 2)[..., None]
        rhs = (vc - gam[..., None] * jnp.einsum('bihk,bhkv->bihv', kc, S)) * bc[..., None]
        u = lax.linalg.triangular_solve(m, jnp.swapaxes(rhs, 1, 2), left_side=True, lower=True,
                                        unit_diagonal=True)
        att = jnp.einsum('bihk,bjhk,bijh->bhij', qc, kc, dec_incl)
        o = jnp.einsum('bhij,bhjv->bihv', att, u) + gam[..., None] * jnp.einsum('bihk,bhkv->bihv', qc, S)
        last = cum[:, -1]
        w = jnp.exp(last[:, None] - cum)
        S = jnp.exp(last)[..., None, None] * S + jnp.einsum('bjh,bjhk,bhjv->bhkv', w, kc, u)
        return S, o

    S, o = lax.scan(step, s0.astype(f32), xs)
    return _from_chunks(o, L), S


def _mixer_ab(h, s_gla, s_re, s_im, p, j):
    f32 = jnp.float32
    bsz, L, _ = h.shape
    q, k, v, glr, r, u = _split(h @ p['w_in_ab'][j], (GLA_HEADS * GLA_DK, GLA_HEADS * GLA_DK, HALF,
                                                       GLA_GATE_RANK, HALF, HALF))
    q = q.reshape(bsz, L, GLA_HEADS, GLA_DK) * (GLA_DK ** -0.5)
    k = k.reshape(bsz, L, GLA_HEADS, GLA_DK)
    v = v.reshape(bsz, L, GLA_HEADS, GLA_DV)
    log_a = jax.nn.log_sigmoid((glr @ p['w_gla_gate'][j] + p['b_gla_gate'][j]).astype(f32)) / GLA_GATE_NORM
    log_a = log_a.reshape(bsz, L, GLA_HEADS, GLA_DK)
    o, s_gla_new = _gla_scan(q, k, v, log_a, s_gla)
    o_gla = (_rmsnorm(o, p['g_gla_norm'][j]).reshape(bsz, L, HALF) * jax.nn.silu(r.astype(f32))).astype(h.dtype)
    y, s_re_new, s_im_new = _s5_scan(u.reshape(bsz, L, S5_GROUPS, S5_H), s_re, s_im,
                                     p['s5_lam_re'][j], p['s5_lam_im'][j], p['s5_b_re'][j], p['s5_b_im'][j],
                                     p['s5_c_re'][j], p['s5_c_im'][j], p['s5_d'][j], p['s5_log_dt'][j])
    y = jax.nn.gelu(y.reshape(bsz, L, HALF))
    o_s5 = (y * jax.nn.sigmoid(y @ p['w_s5_glu'][j].astype(f32) + p['b_s5_glu'][j].astype(f32))).astype(h.dtype)
    out = jnp.concatenate([o_gla, o_s5], axis=-1) @ p['w_out_ab'][j]
    return out, s_gla_new, s_re_new, s_im_new


def _mixer_cd(h, s_ssd, c_ssd, s_gdn, c_gdn, p, j):
    f32 = jnp.float32
    bsz, L, _ = h.shape
    R = SSD_HEADS // SSD_GROUPS
    z, xbc, dt_raw, qkv, gate, b_raw, a_raw = _split(
        h @ p['w_in_cd'][j], (HALF, SSD_CONV_DIM, SSD_HEADS, GDN_CONV_DIM, GDN_HEADS * GDN_DV, GDN_HEADS, GDN_HEADS))
    xbc, c_ssd_new = _causal_conv(xbc, c_ssd, p['ssd_conv_w'][j])
    xbc = jax.nn.silu((xbc + p['ssd_conv_b'][j]).astype(f32))
    xs, bm, cm = _split(xbc, (HALF, SSD_GROUPS * SSD_DSTATE, SSD_GROUPS * SSD_DSTATE))
    xs = xs.reshape(bsz, L, SSD_GROUPS, R, SSD_HEADDIM)
    bm = bm.reshape(bsz, L, SSD_GROUPS, SSD_DSTATE)
    cm = cm.reshape(bsz, L, SSD_GROUPS, SSD_DSTATE)
    dt = jax.nn.softplus(dt_raw.astype(f32) + p['ssd_dt_bias'][j].astype(f32)).reshape(bsz, L, SSD_GROUPS, R)
    a = -jnp.exp(p['ssd_a_log'][j].astype(f32)).reshape(SSD_GROUPS, R)
    s0 = s_ssd.reshape(bsz, SSD_GROUPS, R, SSD_HEADDIM, SSD_DSTATE)
    y, s_ssd_new = _ssd_scan(xs * dt[..., None], dt * a, bm, cm, s0)
    y = y + p['ssd_d'][j].astype(f32).reshape(SSD_GROUPS, R)[..., None] * xs
    zg = jax.nn.silu(z.astype(f32)).reshape(bsz, L, SSD_GROUPS, R * SSD_HEADDIM)
    o_ssd = _rmsnorm(y.reshape(bsz, L, SSD_GROUPS, R * SSD_HEADDIM) * zg,
                     p['ssd_norm'][j].reshape(SSD_GROUPS, R * SSD_HEADDIM))
    o_ssd = o_ssd.reshape(bsz, L, HALF).astype(h.dtype)
    s_ssd_new = s_ssd_new.reshape(bsz, SSD_HEADS, SSD_HEADDIM, SSD_DSTATE)
    qkv, c_gdn_new = _causal_conv(qkv, c_gdn, p['gdn_conv_w'][j])
    qkv = jax.nn.silu(qkv.astype(f32))
    q, k, v = _split(qkv, (GDN_HEADS * GDN_DK, GDN_HEADS * GDN_DK, GDN_HEADS * GDN_DV))
    q = _l2norm(q.reshape(bsz, L, GDN_HEADS, GDN_DK)) * (GDN_DK ** -0.5)
    k = _l2norm(k.reshape(bsz, L, GDN_HEADS, GDN_DK))
    v = v.reshape(bsz, L, GDN_HEADS, GDN_DV)
    beta = jax.nn.sigmoid(b_raw.astype(f32))
    g = -jnp.exp(p['gdn_a_log'][j].astype(f32)) * jax.nn.softplus(a_raw.astype(f32) + p['gdn_dt_bias'][j].astype(f32))
    o, s_gdn_new = _gdn_scan(q, k, v, beta, g, s_gdn)
    o_gdn = _rmsnorm(o, p['gdn_norm'][j]) * jax.nn.silu(gate.astype(f32)).reshape(bsz, L, GDN_HEADS, GDN_DV)
    o_gdn = o_gdn.reshape(bsz, L, HALF).astype(h.dtype)
    out = jnp.concatenate([o_ssd, o_gdn], axis=-1) @ p['w_out_cd'][j]
    return out, s_ssd_new, c_ssd_new, s_gdn_new, c_gdn_new


def _mlp(h, w_up, w_down):
    a = jax.nn.relu(h @ w_up)
    return (a * a) @ w_down


def _trunk(x, st, p):
    new = {name: [] for name in STATE_KEYS}
    for i in range(DEPTH):
        j = i // 2
        h = _rmsnorm(x, p['norm_mix'][i])
        if i % 2 == 0:
            mix, s0, s1, s2 = _mixer_ab(h, st['gla'][j], st['s5_re'][j], st['s5_im'][j], p, j)
            for name, val in zip(('gla', 's5_re', 's5_im'), (s0, s1, s2)):
                new[name].append(val)
        else:
            mix, s0, s1, s2, s3 = _mixer_cd(h, st['ssd'][j], st['ssd_conv'][j], st['gdn'][j], st['gdn_conv'][j], p, j)
            for name, val in zip(('ssd', 'ssd_conv', 'gdn', 'gdn_conv'), (s0, s1, s2, s3)):
                new[name].append(val)
        x = x + mix
        x = x + _mlp(_rmsnorm(x, p['norm_mlp'][i]), p['w_up'][i], p['w_down'][i])
    y = _rmsnorm(x, p['norm_final'])
    return y, tuple(jnp.stack(new[name]) for name in STATE_KEYS)


def setup_inputs(seed: int = 0) -> dict:
    key = jax.random.key(seed)
    ks = iter(jax.random.split(key, 64))
    f32 = jnp.float32

    def nrm(shape, scale):
        return jax.random.normal(next(ks), shape, f32) * scale

    def unif(shape, lo, hi):
        return jax.random.uniform(next(ks), shape, f32, lo, hi)

    def gain(shape):
        return 1.0 + nrm(shape, 0.01)

    def dt_bias(shape):
        dt = jnp.exp(unif(shape, math.log(DT_MIN), math.log(DT_MAX)))
        return dt + jnp.log(-jnp.expm1(-dt))

    n_idx = jnp.arange(S5_P, dtype=f32)
    return {
        'x_prompt': nrm((BATCH, SEQ, D_MODEL), 1.0),
        'x_sample': nrm((DEC_BATCH, DEC_SEQ, D_MODEL), 1.0),
        'state_gla': nrm((N_AB, DEC_BATCH, GLA_HEADS, GLA_DK, GLA_DV), 0.5),
        'state_s5_re': nrm((N_AB, DEC_BATCH, S5_GROUPS, S5_P), 0.1),
        'state_s5_im': nrm((N_AB, DEC_BATCH, S5_GROUPS, S5_P), 0.1),
        'state_ssd': nrm((N_CD, DEC_BATCH, SSD_HEADS, SSD_HEADDIM, SSD_DSTATE), 0.1),
        'state_ssd_conv': nrm((N_CD, DEC_BATCH, CONV_W - 1, SSD_CONV_DIM), 1.0),
        'state_gdn': nrm((N_CD, DEC_BATCH, GDN_HEADS, GDN_DK, GDN_DV), 0.1),
        'state_gdn_conv': nrm((N_CD, DEC_BATCH, CONV_W - 1, GDN_CONV_DIM), 1.0),
        'norm_mix': gain((DEPTH, D_MODEL)),
        'norm_mlp': gain((DEPTH, D_MODEL)),
        'norm_final': gain((D_MODEL,)),
        'w_up': nrm((DEPTH, D_MODEL, D_FF), D_MODEL ** -0.5),
        'w_down': nrm((DEPTH, D_FF, D_MODEL), D_FF ** -0.5),
        'w_in_ab': nrm((N_AB, D_MODEL, IN_AB), D_MODEL ** -0.5),
        'w_out_ab': nrm((N_AB, 2 * HALF, D_MODEL), (2 * HALF) ** -0.5),
        'w_gla_gate': nrm((N_AB, GLA_GATE_RANK, GLA_HEADS * GLA_DK), GLA_GATE_RANK ** -0.5),
        'b_gla_gate': nrm((N_AB, GLA_HEADS * GLA_DK), 0.02),
        'g_gla_norm': gain((N_AB, GLA_DV)),
        's5_lam_re': -0.5 + nrm((N_AB, S5_GROUPS, S5_P), 0.01),
        's5_lam_im': math.pi * n_idx + nrm((N_AB, S5_GROUPS, S5_P), 0.01),
        's5_b_re': nrm((N_AB, S5_GROUPS, S5_P, S5_H), (2 * S5_H) ** -0.5),
        's5_b_im': nrm((N_AB, S5_GROUPS, S5_P, S5_H), (2 * S5_H) ** -0.5),
        's5_c_re': nrm((N_AB, S5_GROUPS, S5_H, S5_P), (2 * S5_P) ** -0.5),
        's5_c_im': nrm((N_AB, S5_GROUPS, S5_H, S5_P), (2 * S5_P) ** -0.5),
        's5_d': nrm((N_AB, S5_GROUPS, S5_H), 1.0),
        's5_log_dt': unif((N_AB, S5_GROUPS), math.log(DT_MIN), math.log(DT_MAX)),
        'w_s5_glu': nrm((N_AB, HALF, HALF), HALF ** -0.5),
        'b_s5_glu': nrm((N_AB, HALF), 0.02),
        'w_in_cd': nrm((N_CD, D_MODEL, IN_CD), D_MODEL ** -0.5),
        'w_out_cd': nrm((N_CD, 2 * HALF, D_MODEL), (2 * HALF) ** -0.5),
        'ssd_conv_w': nrm((N_CD, CONV_W, SSD_CONV_DIM), CONV_W ** -0.5),
        'ssd_conv_b': nrm((N_CD, SSD_CONV_DIM), 0.02),
        'ssd_dt_bias': dt_bias((N_CD, SSD_HEADS)),
        'ssd_a_log': jnp.log(unif((N_CD, SSD_HEADS), 1.0, 16.0)),
        'ssd_d': 1.0 + nrm((N_CD, SSD_HEADS), 0.1),
        'ssd_norm': gain((N_CD, HALF)),
        'gdn_conv_w': nrm((N_CD, CONV_W, GDN_CONV_DIM), CONV_W ** -0.5),
        'gdn_a_log': jnp.log(unif((N_CD, GDN_HEADS), 1.0, 16.0)),
        'gdn_dt_bias': dt_bias((N_CD, GDN_HEADS)),
        'gdn_norm': gain((N_CD, GDN_DV)),
    }


def reference(x_prompt, x_sample, state_gla, state_s5_re, state_s5_im, state_ssd, state_ssd_conv,
              state_gdn, state_gdn_conv, norm_mix, norm_mlp, norm_final, w_up, w_down,
              w_in_ab, w_out_ab, w_gla_gate, b_gla_gate, g_gla_norm,
              s5_lam_re, s5_lam_im, s5_b_re, s5_b_im, s5_c_re, s5_c_im, s5_d, s5_log_dt,
              w_s5_glu, b_s5_glu, w_in_cd, w_out_cd, ssd_conv_w, ssd_conv_b, ssd_dt_bias,
              ssd_a_log, ssd_d, ssd_norm, gdn_conv_w, gdn_a_log, gdn_dt_bias, gdn_norm):
    f32 = jnp.float32
    p = dict(norm_mix=norm_mix, norm_mlp=norm_mlp, norm_final=norm_final, w_up=w_up, w_down=w_down,
             w_in_ab=w_in_ab, w_out_ab=w_out_ab, w_gla_gate=w_gla_gate, b_gla_gate=b_gla_gate,
             g_gla_norm=g_gla_norm, s5_lam_re=s5_lam_re, s5_lam_im=s5_lam_im, s5_b_re=s5_b_re,
             s5_b_im=s5_b_im, s5_c_re=s5_c_re, s5_c_im=s5_c_im, s5_d=s5_d, s5_log_dt=s5_log_dt,
             w_s5_glu=w_s5_glu, b_s5_glu=b_s5_glu, w_in_cd=w_in_cd, w_out_cd=w_out_cd,
             ssd_conv_w=ssd_conv_w, ssd_conv_b=ssd_conv_b, ssd_dt_bias=ssd_dt_bias, ssd_a_log=ssd_a_log,
             ssd_d=ssd_d, ssd_norm=ssd_norm, gdn_conv_w=gdn_conv_w, gdn_a_log=gdn_a_log,
             gdn_dt_bias=gdn_dt_bias, gdn_norm=gdn_norm)
    bsz = x_prompt.shape[0]
    st_prompt = dict(
        gla=jnp.zeros((N_AB, bsz, GLA_HEADS, GLA_DK, GLA_DV), f32),
        s5_re=jnp.zeros((N_AB, bsz, S5_GROUPS, S5_P), f32),
        s5_im=jnp.zeros((N_AB, bsz, S5_GROUPS, S5_P), f32),
        ssd=jnp.zeros((N_CD, bsz, SSD_HEADS, SSD_HEADDIM, SSD_DSTATE), f32),
        ssd_conv=jnp.zeros((N_CD, bsz, CONV_W - 1, SSD_CONV_DIM), x_prompt.dtype),
        gdn=jnp.zeros((N_CD, bsz, GDN_HEADS, GDN_DK, GDN_DV), f32),
        gdn_conv=jnp.zeros((N_CD, bsz, CONV_W - 1, GDN_CONV_DIM), x_prompt.dtype))
    st_sample = dict(gla=state_gla, s5_re=state_s5_re, s5_im=state_s5_im, ssd=state_ssd,
                     ssd_conv=state_ssd_conv, gdn=state_gdn, gdn_conv=state_gdn_conv)
    y_prompt, (p_gla, p_s5_re, p_s5_im, p_ssd, p_ssd_conv, p_gdn, p_gdn_conv) = _trunk(x_prompt, st_prompt, p)
    y_sample, (s_gla, s_s5_re, s_s5_im, s_ssd, s_ssd_conv, s_gdn, s_gdn_conv) = _trunk(x_sample, st_sample, p)
    return (y_prompt, y_sample, p_gla, p_s5_re, p_s5_im, p_ssd, p_ssd_conv, p_gdn, p_gdn_conv,
            s_gla, s_s5_re, s_s5_im, s_ssd, s_ssd_conv, s_gdn, s_gdn_conv)
```

```cpp
#include <hip/hip_runtime.h>
#include <hip/hip_cooperative_groups.h>
#include <cstdio>
#include <cstdint>
namespace cg = cooperative_groups;

#ifndef MULTI_LAUNCH
#define MULTI_LAUNCH 0
#endif

typedef unsigned short u16;
typedef __attribute__((ext_vector_type(8))) short bf16x8;
typedef __attribute__((ext_vector_type(16))) float f32x16;

constexpr int T_ALL = 16512;
constexpr int T_P = 16384;
constexpr int N_AB = 2176;
constexpr int N_CD = 3712;
constexpr int LDS_BYTES = 77824;
constexpr int SJ_OFF = 77808;
constexpr int LP_OFF = 77440;
constexpr int XB_ST_OFF = 77792;

enum { I_XP = 0, I_XS, I_ST_GLA, I_ST_S5RE, I_ST_S5IM, I_ST_SSD, I_ST_SSDC, I_ST_GDN, I_ST_GDNC, I_NORM_MIX, I_NORM_MLP,
       I_NORM_FINAL, I_W_UP, I_W_DOWN, I_W_IN_AB, I_W_OUT_AB, I_W_GLA_GATE, I_B_GLA_GATE, I_G_GLA_NORM, I_S5_LAM_RE,
       I_S5_LAM_IM, I_S5_B_RE, I_S5_B_IM, I_S5_C_RE, I_S5_C_IM, I_S5_D, I_S5_LOG_DT, I_W_S5_GLU, I_B_S5_GLU, I_W_IN_CD,
       I_W_OUT_CD, I_SSD_CONV_W, I_SSD_CONV_B, I_SSD_DT_BIAS, I_SSD_A_LOG, I_SSD_D, I_SSD_NORM, I_GDN_CONV_W,
       I_GDN_A_LOG, I_GDN_DT_BIAS, I_GDN_NORM, N_INPUTS };

constexpr size_t O_Y = 0;
constexpr size_t O_PGLA = (size_t)T_ALL * 1024;
constexpr size_t O_PS5RE = O_PGLA + 8 * 4 * 64 * 128;
constexpr size_t O_PS5IM = O_PS5RE + 8 * 32 * 64;
constexpr size_t O_PSSD = O_PS5IM + 8 * 32 * 64;
constexpr size_t O_PSSDC = O_PSSD + 8 * 8 * 64 * 128;
constexpr size_t O_PGDN = O_PSSDC + 8 * 3 * 1024;
constexpr size_t O_PGDNC = O_PGDN + 8 * 4 * 128 * 128;
constexpr size_t O_SGLA = O_PGDNC + 8 * 3 * 1536;
constexpr size_t O_SS5RE = O_SGLA + (size_t)128 * 4 * 64 * 128;
constexpr size_t O_SS5IM = O_SS5RE + 128 * 32 * 64;
constexpr size_t O_SSSD = O_SS5IM + 128 * 32 * 64;
constexpr size_t O_SSSDC = O_SSSD + (size_t)128 * 8 * 64 * 128;
constexpr size_t O_SGDN = O_SSSDC + 128 * 3 * 1024;
constexpr size_t O_SGDNC = O_SGDN + (size_t)128 * 4 * 128 * 128;
constexpr size_t O_END = O_SGDNC + 128 * 3 * 1536;

constexpr size_t WS_W = 0;
constexpr size_t W_INAB = 0;
constexpr size_t W_GLU = W_INAB + (size_t)N_AB * 1024 * 2;
constexpr size_t W_OUTAB = W_GLU + 512 * 512 * 2;
constexpr size_t W_UP0 = W_OUTAB + 1024 * 1024 * 2;
constexpr size_t W_DOWN0 = W_UP0 + (size_t)4096 * 1024 * 2;
constexpr size_t W_INCD = 0;
constexpr size_t W_OUTCD = W_INCD + (size_t)N_CD * 1024 * 2;
constexpr size_t W_UP1 = W_OUTCD + 1024 * 1024 * 2;
constexpr size_t W_DOWN1 = W_UP1 + (size_t)4096 * 1024 * 2;
constexpr size_t WS_W_SIZE = W_DOWN1 + (size_t)4096 * 1024 * 2;
constexpr size_t WS_HC = WS_W + WS_W_SIZE;
constexpr size_t WS_R1 = WS_HC + (size_t)T_ALL * 1024 * 2;
constexpr size_t R1_SIZE = (size_t)T_ALL * 4096 * 2;
constexpr size_t R1_PAB = 0;
constexpr size_t R1_OG = R1_PAB + (size_t)T_ALL * N_AB * 2;
constexpr size_t R1_YBF = R1_OG + (size_t)T_ALL * 512 * 4;
constexpr size_t R1_PZG = 0;
constexpr size_t R1_PX = R1_PZG + (size_t)T_ALL * 1040 * 2;
constexpr size_t R1_YS = R1_PX;
constexpr size_t R1_OGD = R1_YS + (size_t)T_ALL * 512 * 4;
constexpr size_t R1_AWS = R1_OGD + (size_t)T_ALL * 512 * 4;
constexpr size_t R1_ATT = R1_AWS + (size_t)1536 * 4096 * 2;
static_assert(R1_ATT + (size_t)1536 * 4096 * 2 <= R1_SIZE, "R1 overflow");
static_assert(R1_YBF + (size_t)T_ALL * 512 * 2 <= R1_SIZE, "R1 overflow");
constexpr size_t WS_QKV = WS_R1 + R1_SIZE;
constexpr size_t WS_SC = WS_QKV + (size_t)T_ALL * 1536 * 2;
constexpr size_t WS_CTR = WS_SC + (size_t)T_ALL * 16 * 4;
constexpr size_t WS_BAR = WS_CTR + 256;
constexpr size_t WS_SLAB = WS_BAR + 16384;
constexpr size_t WS_END = WS_SLAB + (size_t)4 * 128 * 1024 * 4;

#define GLOBAL_AS __attribute__((address_space(1)))
typedef GLOBAL_AS float gf32;
typedef GLOBAL_AS u16 gu16;
typedef GLOBAL_AS char gchar;
typedef GLOBAL_AS unsigned guint;
typedef GLOBAL_AS uint4 guint4;
typedef GLOBAL_AS uint2 guint2;
typedef GLOBAL_AS float4 gfloat4;
struct Params {
  const float* in_[N_INPUTS];
  float* out_;
  char* ws_;
  int ph_lo, ph_hi;
  __device__ __forceinline__ const gf32* in(int i) const { return (const gf32*)in_[i]; }
  __device__ __forceinline__ gf32* out() const { return (gf32*)out_; }
  __device__ __forceinline__ gchar* ws() const { return (gchar*)ws_; }
};

typedef unsigned __attribute__((ext_vector_type(4))) u32x4_t;
typedef unsigned __attribute__((ext_vector_type(2))) u32x2_t;
typedef float __attribute__((ext_vector_type(4))) f32x4_t;
__device__ __forceinline__ uint4 gld16(const GLOBAL_AS void* p) { const u32x4_t v = *(const GLOBAL_AS u32x4_t*)p; return make_uint4(v.x, v.y, v.z, v.w); }
__device__ __forceinline__ void gst16(GLOBAL_AS void* p, uint4 v) { u32x4_t t; t.x = v.x; t.y = v.y; t.z = v.z; t.w = v.w; *(GLOBAL_AS u32x4_t*)p = t; }
__device__ __forceinline__ uint2 gld8(const GLOBAL_AS void* p) { const u32x2_t v = *(const GLOBAL_AS u32x2_t*)p; return make_uint2(v.x, v.y); }
__device__ __forceinline__ void gst8(GLOBAL_AS void* p, uint2 v) { u32x2_t t; t.x = v.x; t.y = v.y; *(GLOBAL_AS u32x2_t*)p = t; }
__device__ __forceinline__ float4 gldf4(const GLOBAL_AS void* p) { const f32x4_t v = *(const GLOBAL_AS f32x4_t*)p; return make_float4(v.x, v.y, v.z, v.w); }
__device__ __forceinline__ void gstf4(GLOBAL_AS void* p, float4 v) { f32x4_t t; t.x = v.x; t.y = v.y; t.z = v.z; t.w = v.w; *(GLOBAL_AS f32x4_t*)p = t; }
typedef __bf16 bf16v2_t __attribute__((ext_vector_type(2)));
__device__ __forceinline__ unsigned pack2(float a, float b) {
  bf16v2_t v;
  v.x = (__bf16)a;
  v.y = (__bf16)b;
  return __builtin_bit_cast(unsigned, v);
}
__device__ __forceinline__ unsigned pack2_hw(float a, float b) { return pack2(a, b); }
__device__ __forceinline__ u16 f2bf(float f) { return __builtin_bit_cast(u16, (__bf16)f); }
__device__ __forceinline__ float bf2f(u16 h) { return __uint_as_float(((unsigned)h) << 16); }
__device__ __forceinline__ float sigmoidf_(float x) { return 1.f / (1.f + __expf(-x)); }
__device__ __forceinline__ float siluf_(float x) { return x / (1.f + __expf(-x)); }
__device__ __forceinline__ float softplusf_(float x) { return fmaxf(x, 0.f) + __logf(1.f + __expf(-fabsf(x))); }
__device__ __forceinline__ float geluf_(float x) {
  float z = 0.7978845608f * (x + 0.044715f * x * x * x);
  float t = 1.f - 2.f / (__expf(2.f * z) + 1.f);
  return 0.5f * x * (1.f + t);
}
__device__ __forceinline__ float wave_sum(float v) {
#pragma unroll
  for (int d = 32; d >= 1; d >>= 1) v += __shfl_xor(v, d);
  return v;
}
__device__ __forceinline__ float half_sum(float v) {
#pragma unroll
  for (int d = 16; d >= 1; d >>= 1) v += __shfl_xor(v, d);
  return v;
}
__device__ __forceinline__ float wave_scan(float v, int lane) {
#pragma unroll
  for (int d = 1; d < 64; d <<= 1) {
    float t = __shfl_up(v, d);
    if (lane >= d) v += t;
  }
  return v;
}
__device__ __forceinline__ int opaque_tid() {
  int t = threadIdx.x;
  asm volatile("" : "+v"(t));
  return t;
}
#define TROW(r, lane) (((r) & 3) + 8 * ((r) >> 2) + 4 * ((lane) >> 5))

__device__ __forceinline__ void mma_tile(f32x16& acc, const u16* A, int lda, const u16* Bt, int ldb, int K, int lane) {
  const u16* ap = A + (lane & 31) * lda + 8 * (lane >> 5);
  const u16* bp = Bt + (lane & 31) * ldb + 8 * (lane >> 5);
#pragma unroll 4
  for (int k0 = 0; k0 < K; k0 += 16) {
    bf16x8 a = *(const bf16x8*)(ap + k0);
    bf16x8 b = *(const bf16x8*)(bp + k0);
    acc = __builtin_amdgcn_mfma_f32_32x32x16_bf16(a, b, acc, 0, 0, 0);
  }
}
__device__ __forceinline__ void mma_tile_bg(f32x16& acc, const u16* A, int lda, const u16* B, int ldb, int K, int lane) {
  const u16* ap = A + (lane & 31) * lda + 8 * (lane >> 5);
  const u16* bp = B + (8 * (lane >> 5)) * ldb + (lane & 31);
#pragma unroll 2
  for (int k0 = 0; k0 < K; k0 += 16) {
    bf16x8 a = *(const bf16x8*)(ap + k0);
    bf16x8 b;
#pragma unroll
    for (int j = 0; j < 8; ++j) b[j] = (short)bp[(k0 + j) * ldb];
    acc = __builtin_amdgcn_mfma_f32_32x32x16_bf16(a, b, acc, 0, 0, 0);
  }
}
__device__ __forceinline__ f32x16 zero16() {
  f32x16 z;
#pragma unroll
  for (int i = 0; i < 16; ++i) z[i] = 0.f;
  return z;
}
__device__ __forceinline__ int q_next(const Params& p, int qi, char* smem) {
  int* sj = (int*)(smem + SJ_OFF);
  __syncthreads();
  if (threadIdx.x == 0) {
    guint* ctr = (guint*)(p.ws() + WS_CTR) + qi;
    *sj = (int)__hip_atomic_fetch_add(ctr, 1u, __ATOMIC_RELAXED, __HIP_MEMORY_SCOPE_AGENT);
  }
  __syncthreads();
  return *sj;
}
__device__ __forceinline__ void stage_rows128(u16* dst, const gu16* src, size_t ld, int nvalid, int tid) {
  for (int idx = tid; idx < 64 * 16; idx += 256) {
    const int i = idx >> 4, ch = idx & 15;
    uint4 v = make_uint4(0, 0, 0, 0);
    if (i < nvalid) v = gld16(src + (size_t)i * ld + ch * 8);
    *(uint4*)(dst + i * 136 + ch * 8) = v;
  }
}
__device__ __forceinline__ void stage_64x64(u16* dst, const gu16* src, int tid) {
  for (int idx = tid; idx < 64 * 8; idx += 256) {
    const int i = idx >> 3, ch = idx & 7;
    *(uint4*)(dst + i * 72 + ch * 8) = gld16(src + i * 64 + ch * 8);
  }
}

__device__ __forceinline__ int map_col(int type, int n, int nsrc) {
  if (type == 0) return n < nsrc ? n : -1;
  if (type == 1) {
    if (n < 1024) return n;
    if (n < 2048) return n + 16;
    if (n < 2064) return n - 1024;
    return -1;
  }
  if (n < 1024) return n + 512;
  if (n < 2560) return n + 520;
  if (n < 3072) return n - 2560;
  if (n < 3584) return n + 8;
  if (n < 3592) return n - 2048;
  if (n < 3600) return n;
  return -1;
}
__device__ __forceinline__ void convert_tile(const gf32* __restrict__ W, int K, int nsrc, gu16* __restrict__ dst, int ndst, int type,
                                             char* smem, int t) {
  float* tl = (float*)smem;
  const int tid = opaque_tid();
  const int nkt = K / 64;
  const int k0 = (t % nkt) * 64, n0 = (t / nkt) * 64;
  __syncthreads();
  const int c = tid & 63;
  const int sc = map_col(type, n0 + c, nsrc);
#pragma unroll 4
  for (int i = 0; i < 16; ++i) {
    const int r = (tid >> 6) + 4 * i;
    tl[r * 65 + c] = sc >= 0 ? W[(size_t)(k0 + r) * nsrc + sc] : 0.f;
  }
  __syncthreads();
  const int n = tid >> 2, kq = (tid & 3) * 16;
  unsigned pk[8];
#pragma unroll
  for (int j = 0; j < 8; ++j) pk[j] = pack2(tl[(kq + 2 * j) * 65 + n], tl[(kq + 2 * j + 1) * 65 + n]);
  gu16* d = dst + (size_t)(n0 + n) * K + k0 + kq;
  gst16(d, make_uint4(pk[0], pk[1], pk[2], pk[3]));
  gst16(d + 8, make_uint4(pk[4], pk[5], pk[6], pk[7]));
}
__device__ __forceinline__ void convert_weight(const gf32* __restrict__ W, int K, int nsrc, gu16* __restrict__ dst, int ndst, int type,
                               char* smem) {
  const int ntl = (K / 64) * (ndst / 64);
  for (int t = blockIdx.x; t < ntl; t += gridDim.x) convert_tile(W, K, nsrc, dst, ndst, type, smem, t);
}
__device__ __forceinline__ void convert_filler(const Params& p, int layer, int fj, char* smem) {
  gchar* W = p.ws() + WS_W;
  if (layer == 0) {
    if (fj < 64) convert_tile(p.in(I_W_S5_GLU), 512, 512, (gu16*)(W + W_GLU), 512, 0, smem, fj);
    else if (fj < 320) convert_tile(p.in(I_W_OUT_AB), 1024, 1024, (gu16*)(W + W_OUTAB), 1024, 0, smem, fj - 64);
    else if (fj < 1344) convert_tile(p.in(I_W_UP), 1024, 4096, (gu16*)(W + W_UP0), 4096, 0, smem, fj - 320);
    else convert_tile(p.in(I_W_DOWN), 4096, 1024, (gu16*)(W + W_DOWN0), 1024, 0, smem, fj - 1344);
  } else {
    if (fj < 256) convert_tile(p.in(I_W_OUT_CD), 1024, 1024, (gu16*)(W + W_OUTCD), 1024, 0, smem, fj);
    else if (fj < 1280) convert_tile(p.in(I_W_UP) + (size_t)1024 * 4096, 1024, 4096, (gu16*)(W + W_UP1), 4096, 0, smem, fj - 256);
    else convert_tile(p.in(I_W_DOWN) + (size_t)4096 * 1024, 4096, 1024, (gu16*)(W + W_DOWN1), 1024, 0, smem, fj - 1280);
  }
}

__device__ __forceinline__ void norm_phase(const Params& p, int mode, const gf32* __restrict__ g, int slabmode) {
  const int tid = opaque_tid(), lane = tid & 63;
  const int wg = blockIdx.x * 4 + (tid >> 6), nw = gridDim.x * 4;
  gu16* HC = (gu16*)(p.ws() + WS_HC);
  const gf32* slab = (const gf32*)(p.ws() + WS_SLAB);
  float4 gg[4];
#pragma unroll
  for (int m = 0; m < 4; ++m) gg[m] = gldf4(g + m * 256 + lane * 4);
  for (int row0 = wg; row0 < T_ALL; row0 += 2 * nw) {
    float4 v[2][4];
    float ss[2] = {0.f, 0.f};
    bool ok[2], fold[2];
#pragma unroll
    for (int u = 0; u < 2; ++u) {
      const int row = row0 + u * nw;
      ok[u] = row < T_ALL;
      fold[u] = ok[u] && slabmode != 0 && row >= T_P;
      if (ok[u]) {
        const gf32* src;
        if (mode == 0) src = row < T_P ? p.in(I_XP) + (size_t)row * 1024 : p.in(I_XS) + (size_t)(row - T_P) * 1024;
        else src = p.out() + (size_t)row * 1024;
        if (fold[u] && slabmode == 2) src = p.in(I_XS) + (size_t)(row - T_P) * 1024;
#pragma unroll
        for (int m = 0; m < 4; ++m) v[u][m] = gldf4(src + m * 256 + lane * 4);
      } else {
#pragma unroll
        for (int m = 0; m < 4; ++m) v[u][m] = make_float4(0.f, 0.f, 0.f, 0.f);
      }
    }
#pragma unroll
    for (int u = 0; u < 2; ++u) {
      const int row = row0 + u * nw;
      if (fold[u]) {
#pragma unroll
        for (int m = 0; m < 4; ++m) {
#pragma unroll
          for (int s = 0; s < 4; ++s) {
            const float4 t = gldf4(slab + ((size_t)s * 128 + (row - T_P)) * 1024 + m * 256 + lane * 4);
            v[u][m].x += t.x; v[u][m].y += t.y; v[u][m].z += t.z; v[u][m].w += t.w;
          }
          if (mode != 2) gstf4(p.out() + (size_t)row * 1024 + m * 256 + lane * 4, v[u][m]);
        }
      }
#pragma unroll
      for (int m = 0; m < 4; ++m) ss[u] += v[u][m].x * v[u][m].x + v[u][m].y * v[u][m].y + v[u][m].z * v[u][m].z + v[u][m].w * v[u][m].w;
      ss[u] = wave_sum(ss[u]);
    }
#pragma unroll
    for (int u = 0; u < 2; ++u) {
      const int row = row0 + u * nw;
      if (!ok[u]) continue;
      const float rstd = rsqrtf(ss[u] * (1.f / 1024.f) + 1e-6f);
#pragma unroll
      for (int m = 0; m < 4; ++m) {
        const float y0 = v[u][m].x * rstd * gg[m].x, y1 = v[u][m].y * rstd * gg[m].y, y2 = v[u][m].z * rstd * gg[m].z, y3 = v[u][m].w * rstd * gg[m].w;
        if (mode == 2) gstf4(p.out() + (size_t)row * 1024 + m * 256 + lane * 4, make_float4(y0, y1, y2, y3));
        else gst8(HC + (size_t)row * 1024 + m * 256 + lane * 4, make_uint2(pack2(y0, y1), pack2(y2, y3)));
      }
    }
  }
}

__device__ __forceinline__ float4 ld_bf4(const gu16* p) {
  const uint2 r = gld8(p);
  return make_float4(__uint_as_float(r.x << 16), __uint_as_float(r.x & 0xffff0000u), __uint_as_float(r.y << 16),
                     __uint_as_float(r.y & 0xffff0000u));
}
__device__ __forceinline__ void st_bf4(gu16* p, float a, float b, float c, float d) {
  gst8(p, make_uint2(pack2_hw(a, b), pack2_hw(c, d)));
}

enum { EPI_INAB = 0, EPI_GLU, EPI_RES0, EPI_RES, EPI_UP, EPI_INCD, EPI_SLAB };
struct Epi {
  gu16* ob;
  gu16* ob2;
  gf32* of;
  const gf32* x0;
  const gf32* x1;
  const gu16* yb;
  const gf32* bias;
};

template <int EPI>
__device__ __forceinline__ void epi_store4(const Epi& e, int row, int col, float v0, float v1, float v2, float v3) {
  if (EPI == EPI_INAB) {
    st_bf4(e.ob + (size_t)row * N_AB + col, v0, v1, v2, v3);
  } else if (EPI == EPI_GLU) {
    const float4 y = ld_bf4(e.yb + (size_t)row * 512 + col);
    const float4 b = gldf4(e.bias + col);
    st_bf4(e.ob + (size_t)row * 1024 + 512 + col, y.x * sigmoidf_(v0 + b.x), y.y * sigmoidf_(v1 + b.y),
           y.z * sigmoidf_(v2 + b.z), y.w * sigmoidf_(v3 + b.w));
  } else if (EPI == EPI_RES0) {
    const gf32* xr = row < T_P ? e.x0 + (size_t)row * 1024 : e.x1 + (size_t)(row - T_P) * 1024;
    const float4 x = gldf4(xr + col);
    gstf4(e.of + (size_t)row * 1024 + col, make_float4(x.x + v0, x.y + v1, x.z + v2, x.w + v3));
  } else if (EPI == EPI_RES) {
    gf32* o = e.of + (size_t)row * 1024 + col;
    const float4 x = gldf4(o);
    gstf4(o, make_float4(x.x + v0, x.y + v1, x.z + v2, x.w + v3));
  } else if (EPI == EPI_UP) {
    const float r0 = fmaxf(v0, 0.f), r1 = fmaxf(v1, 0.f), r2 = fmaxf(v2, 0.f), r3 = fmaxf(v3, 0.f);
    st_bf4(e.ob + (size_t)row * 4096 + col, r0 * r0, r1 * r1, r2 * r2, r3 * r3);
  } else if (EPI == EPI_SLAB) {
    gstf4(e.of + (size_t)row * 1024 + col, make_float4(v0, v1, v2, v3));
  } else {
    if (col < 2560) st_bf4(e.ob + (size_t)row * 2560 + col, v0, v1, v2, v3);
    else if (col < 3600) st_bf4(e.ob2 + (size_t)row * 1040 + (col - 2560), v0, v1, v2, v3);
  }
}

template <int EPI>
__device__ __forceinline__ void gemm_tile_at(const gu16* __restrict__ A, int lda, const gu16* __restrict__ Bt, int ldb, int nk,
                                             int m0, int n0, const Epi& e, char* smem,
                                             bool prefetched = false, bool has_next = false, int nm0 = 0, int nn0 = 0) {
  u16* As = (u16*)smem;
  u16* Bs = As + 2 * 128 * 72;
  const int tid = opaque_tid(), lane = tid & 63, wm = (tid >> 7) & 1, wn = (tid >> 6) & 1;
  const int wave = __builtin_amdgcn_readfirstlane(tid >> 6);
  const bool isB = wave >= 2;
  const int li0 = (wave & 1) * 9;
  const gu16* gsrc = isB ? Bt + (size_t)n0 * ldb : A + (size_t)m0 * lda;
  const int ld = isB ? ldb : lda;
  int goff[9];
#pragma unroll
  for (int i = 0; i < 9; ++i) {
    const int c = (li0 + i) * 64 + lane, row = c / 9, ch = c - row * 9;
    goff[i] = row * ld + (ch < 8 ? ch : 7) * 8;
  }
  char* lbase = (char*)(isB ? Bs : As) + li0 * 1024;
  f32x16 acc00 = zero16(), acc01 = zero16(), acc10 = zero16(), acc11 = zero16();
#define G_DMA(buf, koff)                                                                                         \
  _Pragma("unroll") for (int i = 0; i < 9; ++i)                                                                  \
    __builtin_amdgcn_global_load_lds((const unsigned*)(gsrc + goff[i] + (koff)), (unsigned*)(lbase + (buf) * 18432 + i * 1024), 16, 0, 0);
#define G_FRAG(ks, A0, A1, B0, B1)                         \
    A0 = *(const bf16x8*)(as + (ks) * 16);                 \
    A1 = *(const bf16x8*)(as + 32 * 72 + (ks) * 16);       \
    B0 = *(const bf16x8*)(bs + (ks) * 16);                 \
    B1 = *(const bf16x8*)(bs + 32 * 72 + (ks) * 16);
#define G_MMA(A0, A1, B0, B1)                                                        \
    acc00 = __builtin_amdgcn_mfma_f32_32x32x16_bf16(B0, A0, acc00, 0, 0, 0);         \
    acc01 = __builtin_amdgcn_mfma_f32_32x32x16_bf16(B1, A0, acc01, 0, 0, 0);         \
    acc10 = __builtin_amdgcn_mfma_f32_32x32x16_bf16(B0, A1, acc10, 0, 0, 0);         \
    acc11 = __builtin_amdgcn_mfma_f32_32x32x16_bf16(B1, A1, acc11, 0, 0, 0);
#define G_COMPUTE(buf)                                                                                   \
  {                                                                                                      \
    const u16* as = As + (buf) * 128 * 72 + (wm * 64 + (lane & 31)) * 72 + 8 * (lane >> 5);              \
    const u16* bs = Bs + (buf) * 128 * 72 + (wn * 64 + (lane & 31)) * 72 + 8 * (lane >> 5);              \
    bf16x8 pa0, pa1, pb0, pb1, qa0, qa1, qb0, qb1;                                                       \
    G_FRAG(0, pa0, pa1, pb0, pb1)                                                                        \
    G_FRAG(1, qa0, qa1, qb0, qb1)                                                                        \
    G_MMA(pa0, pa1, pb0, pb1)                                                                            \
    G_FRAG(2, pa0, pa1, pb0, pb1)                                                                        \
    G_MMA(qa0, qa1, qb0, qb1)                                                                            \
    G_FRAG(3, qa0, qa1, qb0, qb1)                                                                        \
    G_MMA(pa0, pa1, pb0, pb1)                                                                            \
    G_MMA(qa0, qa1, qb0, qb1)                                                                            \
  }
  if (!prefetched) {
    __syncthreads();
    G_DMA(0, 0)
  }
  __syncthreads();
  for (int kt = 0; kt < nk; ++kt) {
    const int cur = kt & 1;
    if (kt + 1 < nk) { G_DMA(cur ^ 1, (kt + 1) * 64) }
    if (cur == 0) G_COMPUTE(0) else G_COMPUTE(1)
    __syncthreads();
  }
  if (has_next) {
    const gu16* gnext = isB ? Bt + (size_t)nn0 * ldb : A + (size_t)nm0 * lda;
#pragma unroll
    for (int i = 0; i < 9; ++i)
      __builtin_amdgcn_global_load_lds((const unsigned*)(gnext + goff[i]), (unsigned*)(lbase + i * 1024), 16, 0, 0);
  }
#undef G_DMA
#undef G_COMPUTE
#undef G_FRAG
#undef G_MMA
  const int rowb = m0 + wm * 64 + (lane & 31), colb = n0 + wn * 64 + 4 * (lane >> 5);
  if (EPI == EPI_RES || EPI == EPI_RES0) {
    const gf32* s0p; const gf32* s1p;
    if (EPI == EPI_RES0) {
      s0p = rowb < T_P ? e.x0 + (size_t)rowb * 1024 : e.x1 + (size_t)(rowb - T_P) * 1024;
      s1p = (rowb + 32) < T_P ? e.x0 + (size_t)(rowb + 32) * 1024 : e.x1 + (size_t)(rowb + 32 - T_P) * 1024;
    } else {
      s0p = e.of + (size_t)rowb * 1024;
      s1p = e.of + (size_t)(rowb + 32) * 1024;
    }
    float4 xr[16];
#pragma unroll
    for (int gq = 0; gq < 4; ++gq) {
      const int c = colb + 8 * gq;
      xr[4 * gq + 0] = gldf4(s0p + c); xr[4 * gq + 1] = gldf4(s0p + c + 32);
      xr[4 * gq + 2] = gldf4(s1p + c); xr[4 * gq + 3] = gldf4(s1p + c + 32);
    }
    gf32* d0p = e.of + (size_t)rowb * 1024;
    gf32* d1p = e.of + (size_t)(rowb + 32) * 1024;
#pragma unroll
    for (int gq = 0; gq < 4; ++gq) {
      const int c = colb + 8 * gq;
      float4 x;
      x = xr[4 * gq + 0]; gstf4(d0p + c, make_float4(x.x + acc00[4 * gq], x.y + acc00[4 * gq + 1], x.z + acc00[4 * gq + 2], x.w + acc00[4 * gq + 3]));
      x = xr[4 * gq + 1]; gstf4(d0p + c + 32, make_float4(x.x + acc01[4 * gq], x.y + acc01[4 * gq + 1], x.z + acc01[4 * gq + 2], x.w + acc01[4 * gq + 3]));
      x = xr[4 * gq + 2]; gstf4(d1p + c, make_float4(x.x + acc10[4 * gq], x.y + acc10[4 * gq + 1], x.z + acc10[4 * gq + 2], x.w + acc10[4 * gq + 3]));
      x = xr[4 * gq + 3]; gstf4(d1p + c + 32, make_float4(x.x + acc11[4 * gq], x.y + acc11[4 * gq + 1], x.z + acc11[4 * gq + 2], x.w + acc11[4 * gq + 3]));
    }
    return;
  }
  if (EPI == EPI_GLU) {
#pragma unroll
    for (int hq = 0; hq < 2; ++hq) {
      float4 yv[8], bv[4];
#pragma unroll
      for (int g2 = 0; g2 < 2; ++g2) {
        const int c = colb + 8 * (2 * hq + g2);
        yv[4 * g2 + 0] = ld_bf4(e.yb + (size_t)rowb * 512 + c); yv[4 * g2 + 1] = ld_bf4(e.yb + (size_t)rowb * 512 + c + 32);
        yv[4 * g2 + 2] = ld_bf4(e.yb + (size_t)(rowb + 32) * 512 + c); yv[4 * g2 + 3] = ld_bf4(e.yb + (size_t)(rowb + 32) * 512 + c + 32);
        bv[2 * g2] = gldf4(e.bias + c); bv[2 * g2 + 1] = gldf4(e.bias + c + 32);
      }
#pragma unroll
      for (int g2 = 0; g2 < 2; ++g2) {
        const int gq = 2 * hq + g2, c = colb + 8 * gq;
        float4 y, b;
        y = yv[4 * g2 + 0]; b = bv[2 * g2];
        st_bf4(e.ob + (size_t)rowb * 1024 + 512 + c, y.x * sigmoidf_(acc00[4 * gq] + b.x), y.y * sigmoidf_(acc00[4 * gq + 1] + b.y), y.z * sigmoidf_(acc00[4 * gq + 2] + b.z), y.w * sigmoidf_(acc00[4 * gq + 3] + b.w));
        y = yv[4 * g2 + 1]; b = bv[2 * g2 + 1];
        st_bf4(e.ob + (size_t)rowb * 1024 + 512 + c + 32, y.x * sigmoidf_(acc01[4 * gq] + b.x), y.y * sigmoidf_(acc01[4 * gq + 1] + b.y), y.z * sigmoidf_(acc01[4 * gq + 2] + b.z), y.w * sigmoidf_(acc01[4 * gq + 3] + b.w));
        y = yv[4 * g2 + 2]; b = bv[2 * g2];
        st_bf4(e.ob + (size_t)(rowb + 32) * 1024 + 512 + c, y.x * sigmoidf_(acc10[4 * gq] + b.x), y.y * sigmoidf_(acc10[4 * gq + 1] + b.y), y.z * sigmoidf_(acc10[4 * gq + 2] + b.z), y.w * sigmoidf_(acc10[4 * gq + 3] + b.w));
        y = yv[4 * g2 + 3]; b = bv[2 * g2 + 1];
        st_bf4(e.ob + (size_t)(rowb + 32) * 1024 + 512 + c + 32, y.x * sigmoidf_(acc11[4 * gq] + b.x), y.y * sigmoidf_(acc11[4 * gq + 1] + b.y), y.z * sigmoidf_(acc11[4 * gq + 2] + b.z), y.w * sigmoidf_(acc11[4 * gq + 3] + b.w));
      }
    }
    return;
  }
#pragma unroll
  for (int gq = 0; gq < 4; ++gq) {
    const int c = colb + 8 * gq;
    epi_store4<EPI>(e, rowb, c, acc00[4 * gq], acc00[4 * gq + 1], acc00[4 * gq + 2], acc00[4 * gq + 3]);
    epi_store4<EPI>(e, rowb, c + 32, acc01[4 * gq], acc01[4 * gq + 1], acc01[4 * gq + 2], acc01[4 * gq + 3]);
    epi_store4<EPI>(e, rowb + 32, c, acc10[4 * gq], acc10[4 * gq + 1], acc10[4 * gq + 2], acc10[4 * gq + 3]);
    epi_store4<EPI>(e, rowb + 32, c + 32, acc11[4 * gq], acc11[4 * gq + 1], acc11[4 * gq + 2], acc11[4 * gq + 3]);
    __builtin_amdgcn_sched_barrier(0);
  }
}

template <int EPI>
__device__ __forceinline__ void gemm_tile(const gu16* __restrict__ A, int lda, const gu16* __restrict__ Bt, int K, int ntn, const Epi& e,
                                          char* smem, int tile) {
  gemm_tile_at<EPI>(A, lda, Bt, K, K / 64, (tile / ntn) * 128, (tile % ntn) * 128, e, smem);
}
template <int EPI>
__device__ __forceinline__ void gemm_phase_n(const gu16* __restrict__ A, int lda, const gu16* __restrict__ Bt, int K, int ntn, int ntiles,
                                             const Epi& e, char* smem) {
  bool pf = false;
  for (int tile = blockIdx.x; tile < ntiles; tile += gridDim.x) {
    const int nt = tile + gridDim.x;
    const bool hn = nt < ntiles;
    gemm_tile_at<EPI>(A, lda, Bt, K, K / 64, (tile / ntn) * 128, (tile % ntn) * 128, e, smem, pf, hn, (nt / ntn) * 128, (nt % ntn) * 128);
    pf = hn;
  }
}
template <int EPI>
__device__ __forceinline__ void gemm_phase(const gu16* __restrict__ A, int lda, const gu16* __restrict__ Bt, int K, int ntn, const Epi& e,
                           char* smem) {
  gemm_phase_n<EPI>(A, lda, Bt, K, ntn, 129 * ntn, e, smem);
}
template <int EPI>
__device__ __forceinline__ void gemm_phase_xcd(const gu16* __restrict__ A, int lda, const gu16* __restrict__ Bt, int K, int ntn, const Epi& e,
                                               char* smem) {
  const int ntiles = 129 * ntn, C = (ntiles + 7) >> 3;
  bool pf = false;
  for (int j = blockIdx.x; j < 8 * C; j += gridDim.x) {
    const int tile = (j & 7) * C + (j >> 3);
    const int jn = j + gridDim.x, tn = (jn & 7) * C + (jn >> 3);
    const bool hn = jn < 8 * C && tn < ntiles;
    if (tile < ntiles) {
      gemm_tile_at<EPI>(A, lda, Bt, K, K / 64, (tile / ntn) * 128, (tile % ntn) * 128, e, smem, pf, hn, (tn / ntn) * 128, (tn % ntn) * 128);
      pf = hn;
    }
  }
}
template <int EPI>
__device__ __forceinline__ void gemm_res_phase(const gu16* __restrict__ A, int lda, const gu16* __restrict__ Bt, int K, const Epi& e,
                                               gf32* slab, char* smem) {
  bool pf = false;
  for (int job = blockIdx.x; job < 1024 + 32; job += gridDim.x) {
    if (job < 1024) {
      const int r = job >> 9, jj = job & 511, x = jj & 7, q = jj >> 3;
      const int jn = job + gridDim.x;
      const bool hn = jn < 1024;
      const int rn = jn >> 9, jjn = jn & 511, xn = jjn & 7, qn = jjn >> 3;
      gemm_tile_at<EPI>(A, lda, Bt, K, K / 64, (64 * r + 8 * x + (q >> 3)) * 128, (q & 7) * 128, e, smem, pf, hn,
                        (64 * rn + 8 * xn + (qn >> 3)) * 128, (qn & 7) * 128);
      pf = hn;
    } else {
      const int j = job - 1024, ks = j >> 3, kq = K / 4;
      Epi es = e;
      es.of = slab + (size_t)ks * 128 * 1024 - (size_t)T_P * 1024;
      gemm_tile_at<EPI_SLAB>(A + (size_t)ks * kq, lda, Bt + (size_t)ks * kq, K, kq / 64, T_P, (j & 7) * 128, es, smem);
    }
  }
}

constexpr size_t GA_OFF = 0;
constexpr size_t GK_OFF = GA_OFF + (size_t)1536 * 64 * 128 * 2;
constexpr size_t GE_OFF = GK_OFF + (size_t)1536 * 64 * 64 * 2;
static_assert(GE_OFF + (size_t)1536 * 64 * 4 <= (size_t)T_ALL * 1536 * 2, "GLA prepass buffers must fit the QKV region");

__device__ __forceinline__ void gla_prep_unit(const Params& p, int u, char* smem) {
  const int tid = opaque_tid(), lane = tid & 63, wave = tid >> 6;
  int h, nvalid;
  size_t row0;
  if (u < 1024) { const int chain = u >> 5; h = chain & 3; row0 = (size_t)(chain >> 2) * 2048 + (size_t)(u & 31) * 64; nvalid = 64; }
  else { const int j2 = u - 1024; h = j2 & 3; row0 = (size_t)T_P + (j2 >> 2); nvalid = 1; }
  const gu16* Pab = (const gu16*)(p.ws() + WS_R1 + R1_PAB);
  gu16* GA = (gu16*)(p.ws() + WS_QKV + GA_OFF) + (size_t)u * 8192;
  gu16* GK = (gu16*)(p.ws() + WS_QKV + GK_OFF) + (size_t)u * 4096;
  gf32* GE = (gf32*)(p.ws() + WS_QKV + GE_OFF) + (size_t)u * 64;
  u16* AQ = (u16*)smem;
  u16* Kt = AQ + 64 * 136;
  float* cum = (float*)(Kt + 64 * 72);
  float* glr = cum + 64 * 64;
  float* Wg = glr + 64 * 16;
  float* bg = Wg + 16 * 64;
  const int kk = tid & 63;
  __syncthreads();
  for (int idx = tid; idx < 16 * 64; idx += 256) Wg[idx] = p.in(I_W_GLA_GATE)[(idx >> 6) * 256 + h * 64 + (idx & 63)];
  if (tid < 64) bg[tid] = p.in(I_B_GLA_GATE)[h * 64 + tid];
  for (int idx = tid; idx < 64 * 16; idx += 256) {
    const int i = idx >> 4, r = idx & 15;
    glr[idx] = (i < nvalid) ? bf2f(Pab[(row0 + i) * N_AB + 2048 + r]) : 0.f;
  }
  float qv[16], kv[16];
#pragma unroll
  for (int m = 0; m < 16; ++m) {
    const int i = (tid >> 6) + 4 * m;
    const bool ok = i < nvalid;
    qv[m] = ok ? bf2f(Pab[(row0 + i) * N_AB + h * 64 + kk]) : 0.f;
    kv[m] = ok ? bf2f(Pab[(row0 + i) * N_AB + 256 + h * 64 + kk]) : 0.f;
  }
  __syncthreads();
#pragma unroll 2
  for (int m = 0; m < 16; ++m) {
    const int i = (tid >> 6) + 4 * m;
    float x = bg[kk];
#pragma unroll
    for (int r = 0; r < 16; ++r) x += glr[i * 16 + r] * Wg[r * 64 + kk];
    cum[i * 64 + kk] = (i < nvalid) ? (-softplusf_(-x)) * (1.f / 16.f) : 0.f;
  }
  __syncthreads();
  if (tid < 64) {
    float a = 0.f;
#pragma unroll 1
    for (int i0 = 0; i0 < 64; i0 += 16) {
      float t[16];
#pragma unroll
      for (int u = 0; u < 16; ++u) t[u] = cum[(i0 + u) * 64 + tid];
#pragma unroll
      for (int u = 0; u < 16; ++u) { a += t[u]; cum[(i0 + u) * 64 + tid] = a; }
    }
    GE[tid] = __expf(a);
  }
  __syncthreads();
#pragma unroll
  for (int m = 0; m < 16; ++m) {
    const int i = (tid >> 6) + 4 * m;
    const float cm = cum[i * 64 + kk];
    AQ[i * 136 + 64 + kk] = f2bf(qv[m] * 0.125f * __expf(cm));
    Kt[i * 72 + kk] = f2bf(kv[m] * __expf(-cm));
  }
  __syncthreads();
  {
    const int mi = wave >> 1, ni = wave & 1;
    f32x16 acc = zero16();
    mma_tile(acc, AQ + mi * 32 * 136 + 64, 136, Kt + ni * 32 * 72, 72, 64, lane);
    const int jj = ni * 32 + (lane & 31);
#pragma unroll
    for (int r = 0; r < 16; ++r) {
      const int i = mi * 32 + TROW(r, lane);
      AQ[i * 136 + jj] = f2bf(jj <= i ? acc[r] : 0.f);
    }
  }
  __syncthreads();
  for (int idx = tid; idx < 64 * 16; idx += 256) {
    const int i = idx >> 4, ch = idx & 15;
    gst16(GA + i * 128 + ch * 8, *(const uint4*)(AQ + i * 136 + ch * 8));
  }
  for (int idx = tid; idx < 64 * 8; idx += 256) {
    const int i = idx >> 3, ch = idx & 7;
    gst16(GK + i * 64 + ch * 8, *(const uint4*)(Kt + i * 72 + ch * 8));
  }
}

__device__ __forceinline__ void gla_seq_unit(const Params& p, int job, char* smem) {
  const int tid = opaque_tid(), lane = tid & 63, wave = tid >> 6;
  int tok0, nchunks, nvalid, h, vs, ubase;
  const gf32* s0;
  gf32* sout;
  if (job < 128) {
    const int chain = job >> 2;
    vs = job & 3; h = chain & 3; ubase = chain * 32;
    tok0 = (chain >> 2) * 2048; nchunks = 32; nvalid = 64; s0 = nullptr;
    sout = p.out() + O_PGLA + (size_t)chain * 8192;
  } else {
    const int j2 = job - 128, chain = j2 >> 2;
    vs = j2 & 3; h = chain & 3; ubase = 1024 + chain;
    tok0 = T_P + (chain >> 2); nchunks = 1; nvalid = 1;
    s0 = p.in(I_ST_GLA) + (size_t)chain * 8192;
    sout = p.out() + O_SGLA + (size_t)chain * 8192;
  }
  const gu16* Pab = (const gu16*)(p.ws() + WS_R1 + R1_PAB);
  gf32* OG = (gf32*)(p.ws() + WS_R1 + R1_OG);
  const gu16* GA = (const gu16*)(p.ws() + WS_QKV + GA_OFF);
  const gu16* GK = (const gu16*)(p.ws() + WS_QKV + GK_OFF);
  const gf32* GE = (const gf32*)(p.ws() + WS_QKV + GE_OFF);
  u16* AQ = (u16*)smem;
  u16* Kt = AQ + 64 * 136;
  u16* VS = Kt + 64 * 72;
  float* el = (float*)(VS + 32 * 136);
  __syncthreads();
  f32x16 accS = zero16();
  if (wave < 2) {
    const int k = wave * 32 + (lane & 31);
#pragma unroll
    for (int r = 0; r < 16; ++r) {
      const int v = TROW(r, lane);
      if (s0) accS[r] = s0[(size_t)k * 128 + vs * 32 + v];
      VS[v * 136 + 64 + k] = f2bf(accS[r]);
    }
  }
  const int vj = tid >> 2, vq = (tid & 3) * 8;
  uint4 pa0, pa1, pa2, pa3, pk0, pk1, pv;
  float pe = 0.f;
#define GLA_LOAD(c_)                                                                                     \
  {                                                                                                      \
    const size_t u_ = (size_t)ubase + (c_);                                                              \
    const size_t r0_ = (size_t)tok0 + (size_t)(c_) * 64;                                                 \
    const gu16* ga_ = GA + u_ * 8192;                                                                    \
    const gu16* gk_ = GK + u_ * 4096;                                                                    \
    pa0 = gld16(ga_ + (size_t)(tid + 0) * 8);   pa1 = gld16(ga_ + (size_t)(tid + 256) * 8);              \
    pa2 = gld16(ga_ + (size_t)(tid + 512) * 8); pa3 = gld16(ga_ + (size_t)(tid + 768) * 8);              \
    pk0 = gld16(gk_ + (size_t)(tid + 0) * 8);   pk1 = gld16(gk_ + (size_t)(tid + 256) * 8);              \
    pv = make_uint4(0, 0, 0, 0);                                                                         \
    if (vj < nvalid) pv = gld16(Pab + (r0_ + vj) * N_AB + 512 + h * 128 + vs * 32 + vq);                 \
    if (tid < 64) pe = GE[u_ * 64 + tid];                                                                \
  }
  GLA_LOAD(0)
  for (int c = 0; c < nchunks; ++c) {
    const size_t row0 = (size_t)tok0 + (size_t)c * 64;
    {
      int idx = tid;       *(uint4*)(AQ + (idx >> 4) * 136 + (idx & 15) * 8) = pa0;
      idx = tid + 256;     *(uint4*)(AQ + (idx >> 4) * 136 + (idx & 15) * 8) = pa1;
      idx = tid + 512;     *(uint4*)(AQ + (idx >> 4) * 136 + (idx & 15) * 8) = pa2;
      idx = tid + 768;     *(uint4*)(AQ + (idx >> 4) * 136 + (idx & 15) * 8) = pa3;
      idx = tid;           *(uint4*)(Kt + (idx >> 3) * 72 + (idx & 7) * 8) = pk0;
      idx = tid + 256;     *(uint4*)(Kt + (idx >> 3) * 72 + (idx & 7) * 8) = pk1;
      VS[(vq + 0) * 136 + vj] = (u16)(pv.x & 0xffffu); VS[(vq + 1) * 136 + vj] = (u16)(pv.x >> 16);
      VS[(vq + 2) * 136 + vj] = (u16)(pv.y & 0xffffu); VS[(vq + 3) * 136 + vj] = (u16)(pv.y >> 16);
      VS[(vq + 4) * 136 + vj] = (u16)(pv.z & 0xffffu); VS[(vq + 5) * 136 + vj] = (u16)(pv.z >> 16);
      VS[(vq + 6) * 136 + vj] = (u16)(pv.w & 0xffffu); VS[(vq + 7) * 136 + vj] = (u16)(pv.w >> 16);
      if (tid < 64) el[tid] = pe;
    }
    __syncthreads();
    if (c + 1 < nchunks) GLA_LOAD(c + 1)
    if (wave >= 2) {
      const int mi = wave - 2;
      f32x16 acc = zero16();
      mma_tile(acc, AQ + mi * 32 * 136, 136, VS, 136, 128, lane);
      const int v = lane & 31;
#pragma unroll
      for (int r = 0; r < 16; ++r) {
        const int i = mi * 32 + TROW(r, lane);
        if (i < nvalid) OG[(row0 + i) * 512 + h * 128 + vs * 32 + v] = acc[r];
      }
    } else {
      mma_tile_bg(accS, VS, 136, Kt + wave * 32, 72, 64, lane);
      const float e = el[wave * 32 + (lane & 31)];
#pragma unroll
      for (int r = 0; r < 16; ++r) accS[r] *= e;
    }
    __syncthreads();
    if (wave < 2) {
      const int k = wave * 32 + (lane & 31);
#pragma unroll
      for (int r = 0; r < 16; ++r) VS[TROW(r, lane) * 136 + 64 + k] = f2bf(accS[r]);
    }
  }
#undef GLA_LOAD
  if (wave < 2) {
    const int k = wave * 32 + (lane & 31);
#pragma unroll
    for (int r = 0; r < 16; ++r) sout[(size_t)k * 128 + vs * 32 + TROW(r, lane)] = accS[r];
  }
}

__device__ __forceinline__ void s5_unit(const Params& p, int job, char* smem) {
  const int tid = opaque_tid(), lane = tid & 63, wave = tid >> 6;
  u16* U = (u16*)smem;
  u16* BB = U + 64 * 24;
  u16* CC = BB + 128 * 24;
  u16* Hb = CC + 32 * 136;
  float* BU = (float*)(Hb + 64 * 136);
  float* ar = BU + 64 * 128;
  float* ai = ar + 64;
  const bool seq = job < 256;
  int g, b = 0, half = 0, tok0, nchunks;
  if (seq) { b = job >> 5; g = job & 31; tok0 = b * 2048; nchunks = 32; }
  else { const int j2 = job - 256; g = j2 >> 1; half = j2 & 1; tok0 = T_P + half * 64; nchunks = 1; }
  const gu16* Pab = (const gu16*)(p.ws() + WS_R1 + R1_PAB);
  gu16* Ybf = (gu16*)(p.ws() + WS_R1 + R1_YBF);
  float a_re = 0.f, a_im = 0.f, h_re = 0.f, h_im = 0.f;
  __syncthreads();
  if (tid < 64) {
    const int pp = tid;
    const float lr = p.in(I_S5_LAM_RE)[g * 64 + pp], li = p.in(I_S5_LAM_IM)[g * 64 + pp];
    const float dt = expf(p.in(I_S5_LOG_DT)[g]);
    const float mag = expf(lr * dt);
    float rev = li * dt * 0.15915494309189535f;
    rev -= floorf(rev);
    a_re = mag * __builtin_amdgcn_cosf(rev);
    a_im = mag * __builtin_amdgcn_sinf(rev);
    ar[pp] = a_re; ai[pp] = a_im;
    const float den = lr * lr + li * li;
    const float n_re = a_re - 1.f, n_im = a_im;
    const float k_re = (n_re * lr + n_im * li) / den, k_im = (n_im * lr - n_re * li) / den;
    const gf32* bre = p.in(I_S5_B_RE) + (size_t)(g * 64 + pp) * 16;
    const gf32* bim = p.in(I_S5_B_IM) + (size_t)(g * 64 + pp) * 16;
#pragma unroll
    for (int hh = 0; hh < 16; ++hh) {
      const float br = bre[hh], bi = bim[hh];
      BB[(2 * pp) * 24 + hh] = f2bf(k_re * br - k_im * bi);
      BB[(2 * pp + 1) * 24 + hh] = f2bf(k_re * bi + k_im * br);
    }
  }
  for (int idx = tid; idx < 32 * 128; idx += 256) {
    const int hh = idx >> 7, n = idx & 127, pp = n >> 1;
    float v = 0.f;
    if (hh < 16) v = (n & 1) ? -p.in(I_S5_C_IM)[(size_t)(g * 16 + hh) * 64 + pp] : p.in(I_S5_C_RE)[(size_t)(g * 16 + hh) * 64 + pp];
    CC[hh * 136 + n] = f2bf(v);
  }
  const float dd = p.in(I_S5_D)[g * 16 + (lane & 15)];
  uint4 pu = make_uint4(0, 0, 0, 0);
  if (tid < 128) pu = gld16(Pab + ((size_t)tok0 + (tid >> 1)) * N_AB + 1536 + g * 16 + (tid & 1) * 8);
  for (int c = 0; c < nchunks; ++c) {
    const size_t row0 = (size_t)tok0 + (size_t)c * 64;
    if (tid < 128) *(uint4*)(U + (tid >> 1) * 24 + (tid & 1) * 8) = pu;
    __syncthreads();
    if (c + 1 < nchunks && tid < 128) pu = gld16(Pab + (row0 + 64 + (tid >> 1)) * N_AB + 1536 + g * 16 + (tid & 1) * 8);
    for (int t = wave; t < 8; t += 4) {
      const int mi = t >> 2, ni = t & 3;
      f32x16 acc = zero16();
      mma_tile(acc, U + mi * 32 * 24, 24, BB + ni * 32 * 24, 24, 16, lane);
      const int n = ni * 32 + (lane & 31);
#pragma unroll
      for (int r = 0; r < 16; ++r) BU[(mi * 32 + TROW(r, lane)) * 128 + n] = acc[r];
    }
    __syncthreads();
    if (seq) {
      if (tid < 64) {
#pragma unroll 1
        for (int i0 = 0; i0 < 64; i0 += 32) {
          float2 bu[32];
#pragma unroll
          for (int u = 0; u < 32; ++u) bu[u] = *(const float2*)(BU + (i0 + u) * 128 + 2 * tid);
          unsigned hw[32];
#pragma unroll
          for (int u = 0; u < 32; ++u) {
            const float nr = a_re * h_re - a_im * h_im + bu[u].x;
            const float ni_ = a_re * h_im + a_im * h_re + bu[u].y;
            h_re = nr; h_im = ni_;
            hw[u] = pack2_hw(nr, ni_);
          }
#pragma unroll
          for (int u = 0; u < 32; ++u) *(unsigned*)(Hb + (i0 + u) * 136 + 2 * tid) = hw[u];
        }
      }
    } else {
#pragma unroll 4
      for (int m = 0; m < 16; ++m) {
        const int idx = tid + 256 * m, i = idx >> 6, pp = idx & 63;
        const int tok = half * 64 + i;
        const float h0r = p.in(I_ST_S5RE)[((size_t)tok * 32 + g) * 64 + pp];
        const float h0i = p.in(I_ST_S5IM)[((size_t)tok * 32 + g) * 64 + pp];
        const float xr = ar[pp], xi = ai[pp];
        const float nr = xr * h0r - xi * h0i + BU[i * 128 + 2 * pp];
        const float ni_ = xr * h0i + xi * h0r + BU[i * 128 + 2 * pp + 1];
        *(unsigned*)(Hb + i * 136 + 2 * pp) = pack2(nr, ni_);
        p.out()[O_SS5RE + ((size_t)tok * 32 + g) * 64 + pp] = nr;
        p.out()[O_SS5IM + ((size_t)tok * 32 + g) * 64 + pp] = ni_;
      }
    }
    __syncthreads();
    {
      typedef __attribute__((ext_vector_type(4))) float f32x4v;
      f32x4v acc = {0.f, 0.f, 0.f, 0.f};
      const u16* ap = Hb + (wave * 16 + (lane & 15)) * 136 + 8 * (lane >> 4);
      const u16* bp = CC + (lane & 15) * 136 + 8 * (lane >> 4);
#pragma unroll
      for (int ks = 0; ks < 4; ++ks) {
        const bf16x8 a = *(const bf16x8*)(ap + ks * 32);
        const bf16x8 b = *(const bf16x8*)(bp + ks * 32);
        acc = __builtin_amdgcn_mfma_f32_16x16x32_bf16(a, b, acc, 0, 0, 0);
      }
      const int hh = lane & 15;
#pragma unroll
      for (int r = 0; r < 4; ++r) {
        const int i = wave * 16 + (lane >> 4) * 4 + r;
        const float y = acc[r] + dd * bf2f(U[i * 24 + hh]);
        Ybf[(row0 + i) * 512 + g * 16 + hh] = f2bf(geluf_(y));
      }
    }
    __syncthreads();
  }
  if (seq && tid < 64) {
    p.out()[O_PS5RE + ((size_t)b * 32 + g) * 64 + tid] = h_re;
    p.out()[O_PS5IM + ((size_t)b * 32 + g) * 64 + tid] = h_im;
  }
}

__device__ __forceinline__ void ssd_unit(const Params& p, int job, char* smem) {
  const int tid = opaque_tid(), lane = tid & 63, wave = tid >> 6;
  int tok0, nchunks, nvalid, hh, ps;
  const gf32* s0;
  gf32* sout;
  if (job < 128) {
    const int chain = job >> 1;
    ps = job & 1; hh = chain & 7;
    tok0 = (chain >> 3) * 2048; nchunks = 32; nvalid = 64; s0 = nullptr;
    sout = p.out() + O_PSSD + (size_t)chain * 8192;
  } else {
    const int j2 = job - 128, chain = j2 >> 1;
    ps = j2 & 1; hh = chain & 7;
    tok0 = T_P + (chain >> 3); nchunks = 1; nvalid = 1;
    s0 = p.in(I_ST_SSD) + (size_t)chain * 8192;
    sout = p.out() + O_SSSD + (size_t)chain * 8192;
  }
  const int g = hh >> 2;
  const gu16* XBC = (const gu16*)(p.ws() + WS_HC);
  const gf32* SC = (const gf32*)(p.ws() + WS_SC);
  gf32* YS = (gf32*)(p.ws() + WS_R1 + R1_YS);
  u16* Cm = (u16*)smem;
  u16* Bm = Cm + 64 * 136;
  u16* G = Bm + 64 * 136;
  u16* XT = G + 64 * 72;
  u16* XW = XT + 32 * 72;
  u16* SB = XW + 32 * 72;
  float* cum = (float*)(SB + 32 * 136);
  float* dtv = cum + 64;
  const float a = -expf(p.in(I_SSD_A_LOG)[hh]);
  __syncthreads();
  f32x16 accS = zero16();
  {
    const int n = wave * 32 + (lane & 31);
#pragma unroll
    for (int r = 0; r < 16; ++r) {
      const int pr = TROW(r, lane);
      if (s0) accS[r] = s0[(size_t)(ps * 32 + pr) * 128 + n];
      SB[pr * 136 + n] = f2bf(accS[r]);
    }
  }
  const int xj = tid >> 2, xq = (tid & 3) * 8;
  uint4 pb0, pb1, pb2, pb3, pc0, pc1, pc2, pc3, px;
  float pdt = 0.f;
  const uint4 z4 = make_uint4(0, 0, 0, 0);
#define SSD_LD1(dst, m_, off_) { const int idx_ = tid + 256 * (m_); const int i_ = idx_ >> 4; \
    dst = (i_ < nvalid) ? gld16(XBC + (r0_ + i_) * 1024 + (off_) + g * 128 + (idx_ & 15) * 8) : z4; }
#define SSD_LOAD(c_)                                                                     \
  {                                                                                      \
    const size_t r0_ = (size_t)tok0 + (size_t)(c_) * 64;                                 \
    SSD_LD1(pb0, 0, 512) SSD_LD1(pb1, 1, 512) SSD_LD1(pb2, 2, 512) SSD_LD1(pb3, 3, 512)  \
    SSD_LD1(pc0, 0, 768) SSD_LD1(pc1, 1, 768) SSD_LD1(pc2, 2, 768) SSD_LD1(pc3, 3, 768)  \
    px = (xj < nvalid) ? gld16(XBC + (r0_ + xj) * 1024 + hh * 64 + ps * 32 + xq) : z4;   \
    if (tid < 64) pdt = (tid < nvalid) ? SC[(r0_ + tid) * 16 + hh] : 0.f;                \
  }
#define LDS_ST136(base, m_, v_) { const int idx_ = tid + 256 * (m_); *(uint4*)((base) + (idx_ >> 4) * 136 + (idx_ & 15) * 8) = (v_); }
  SSD_LOAD(0)
  for (int c = 0; c < nchunks; ++c) {
    const size_t row0 = (size_t)tok0 + (size_t)c * 64;
    LDS_ST136(Bm, 0, pb0) LDS_ST136(Bm, 1, pb1) LDS_ST136(Bm, 2, pb2) LDS_ST136(Bm, 3, pb3)
    LDS_ST136(Cm, 0, pc0) LDS_ST136(Cm, 1, pc1) LDS_ST136(Cm, 2, pc2) LDS_ST136(Cm, 3, pc3)
    if (tid < 64) { dtv[tid] = pdt; cum[tid] = wave_scan(pdt * a, lane); }
    const uint4 xc = px;
    __syncthreads();
    const float last = cum[63];
    {
      const float dtj = dtv[xj], w = __expf(last - cum[xj]);
      const unsigned xw[4] = {xc.x, xc.y, xc.z, xc.w};
#pragma unroll
      for (int e = 0; e < 8; ++e) {
        const float x = __uint_as_float((e & 1) ? (xw[e >> 1] & 0xffff0000u) : (xw[e >> 1] << 16)) * dtj;
        XT[(xq + e) * 72 + xj] = f2bf(x);
        XW[(xq + e) * 72 + xj] = f2bf(x * w);
      }
    }
    if (c + 1 < nchunks) SSD_LOAD(c + 1)
    {
      const int mi = wave >> 1, ni = wave & 1;
      f32x16 acc = zero16();
      mma_tile(acc, Cm + mi * 32 * 136, 136, Bm + ni * 32 * 136, 136, 128, lane);
      const int j = ni * 32 + (lane & 31);
      const float cj = cum[j];
      float ci[16];
#pragma unroll
      for (int r = 0; r < 16; ++r) ci[r] = cum[mi * 32 + TROW(r, lane)];
#pragma unroll
      for (int r = 0; r < 16; ++r) {
        const int i = mi * 32 + TROW(r, lane);
        G[i * 72 + j] = f2bf(j <= i ? acc[r] * __expf(ci[r] - cj) : 0.f);
      }
    }
    __syncthreads();
    if (wave < 2) {
      const int mi = wave;
      f32x16 acc1 = zero16(), acc2 = zero16();
      mma_tile(acc1, G + mi * 32 * 72, 72, XT, 72, 64, lane);
      mma_tile(acc2, Cm + mi * 32 * 136, 136, SB, 136, 128, lane);
      const int pr = lane & 31;
#pragma unroll
      for (int r = 0; r < 16; ++r) {
        const int i = mi * 32 + TROW(r, lane);
        if (i < nvalid) YS[(row0 + i) * 512 + hh * 64 + ps * 32 + pr] = acc1[r] + __expf(cum[i]) * acc2[r];
      }
    }
    {
      const float el = __expf(last);
#pragma unroll
      for (int r = 0; r < 16; ++r) accS[r] *= el;
      mma_tile_bg(accS, XW, 72, Bm + wave * 32, 136, 64, lane);
    }
    __syncthreads();
    {
      const int n = wave * 32 + (lane & 31);
#pragma unroll
      for (int r = 0; r < 16; ++r) SB[TROW(r, lane) * 136 + n] = f2bf(accS[r]);
    }
  }
#undef SSD_LOAD
#undef SSD_LD1
  {
    const int n = wave * 32 + (lane & 31);
#pragma unroll
    for (int r = 0; r < 16; ++r) sout[(size_t)(ps * 32 + TROW(r, lane)) * 128 + n] = accS[r];
  }
}

__device__ __forceinline__ void gdn_prep_unit(const Params& p, int u, char* smem) {
  const int tid = opaque_tid(), lane = tid & 63, wave = tid >> 6;
  int h, nvalid;
  size_t row0;
  if (u < 1024) { const int chain = u >> 5; h = chain & 3; row0 = (size_t)(chain >> 2) * 2048 + (size_t)(u & 31) * 64; nvalid = 64; }
  else { const int j2 = u - 1024; h = j2 & 3; row0 = (size_t)T_P + (j2 >> 2); nvalid = 1; }
  const gu16* QKV = (const gu16*)(p.ws() + WS_QKV);
  const gf32* SC = (const gf32*)(p.ws() + WS_SC);
  gu16* Aws = (gu16*)(p.ws() + WS_R1 + R1_AWS) + (size_t)u * 4096;
  gu16* ATTws = (gu16*)(p.ws() + WS_R1 + R1_ATT) + (size_t)u * 4096;
  u16* Kn = (u16*)smem;
  u16* Qn = Kn + 64 * 136;
  float* Mf = (float*)(Qn + 64 * 136);
  float* Xs = Mf + 64 * 68;
  float* cum = Xs + 64 * 64;
  float* beta = cum + 64;
  __syncthreads();
  stage_rows128(Qn, QKV + row0 * 1536 + h * 128, 1536, nvalid, tid);
  stage_rows128(Kn, QKV + row0 * 1536 + 512 + h * 128, 1536, nvalid, tid);
  if (tid < 64) {
    const bool ok = tid < nvalid;
    beta[tid] = ok ? SC[(row0 + tid) * 16 + 8 + h] : 0.f;
    cum[tid] = wave_scan(ok ? SC[(row0 + tid) * 16 + 12 + h] : 0.f, lane);
  }
  __syncthreads();
  {
    const int mi = wave >> 1, ni = wave & 1;
    f32x16 acc = zero16();
    mma_tile(acc, Kn + mi * 32 * 136, 136, Kn + ni * 32 * 136, 136, 128, lane);
    f32x16 acq = zero16();
    mma_tile(acq, Qn + mi * 32 * 136, 136, Kn + ni * 32 * 136, 136, 128, lane);
    const int j = ni * 32 + (lane & 31);
    const float cj = cum[j];
    float ci[16], bi[16];
#pragma unroll
    for (int r = 0; r < 16; ++r) { const int i = mi * 32 + TROW(r, lane); ci[r] = cum[i]; bi[r] = beta[i]; }
#pragma unroll
    for (int r = 0; r < 16; ++r) {
      const int i = mi * 32 + TROW(r, lane);
      const float dec = __expf(ci[r] - cj);
      Mf[j * 68 + i] = (j < i) ? bi[r] * acc[r] * dec : 0.f;
      ATTws[i * 64 + j] = f2bf(j <= i ? acq[r] * dec : 0.f);
    }
  }
  __syncthreads();
  if (wave == 0) {
    if (nvalid == 64) {
#pragma unroll 1
      for (int rb = 0; rb < 4; ++rb) {
        float s[16];
#pragma unroll
        for (int r = 0; r < 16; ++r) s[r] = (rb * 16 + r == lane) ? 1.f : 0.f;
#pragma unroll 2
        for (int j = 0; j < rb * 16; ++j) {
          const float xj = Xs[j * 64 + lane];
          const float4* mp = (const float4*)(Mf + j * 68 + rb * 16);
          const float4 m0 = mp[0], m1 = mp[1], m2 = mp[2], m3 = mp[3];
          s[0] -= m0.x * xj; s[1] -= m0.y * xj; s[2] -= m0.z * xj; s[3] -= m0.w * xj;
          s[4] -= m1.x * xj; s[5] -= m1.y * xj; s[6] -= m1.z * xj; s[7] -= m1.w * xj;
          s[8] -= m2.x * xj; s[9] -= m2.y * xj; s[10] -= m2.z * xj; s[11] -= m2.w * xj;
          s[12] -= m3.x * xj; s[13] -= m3.y * xj; s[14] -= m3.z * xj; s[15] -= m3.w * xj;
        }
#pragma unroll
        for (int q = 0; q < 16; ++q) {
          const float xq = s[q];
          Xs[(rb * 16 + q) * 64 + lane] = xq;
          Aws[(rb * 16 + q) * 64 + lane] = f2bf(xq);
#pragma unroll
          for (int r = q + 1; r < 16; ++r) s[r] -= Mf[(rb * 16 + q) * 68 + rb * 16 + r] * xq;
        }
      }
    } else {
#pragma unroll 8
      for (int i = 0; i < 64; ++i) Aws[i * 64 + lane] = (i == lane) ? (u16)0x3F80 : (u16)0;
    }
  }
}

__device__ __forceinline__ void gdn_unit(const Params& p, int job, char* smem) {
  const int tid = opaque_tid(), lane = tid & 63, wave = tid >> 6;
  int tok0, nchunks, nvalid, h, vs, ubase;
  const gf32* s0;
  gf32* sout;
  if (job < 128) {
    const int chain = job >> 2;
    vs = job & 3; h = chain & 3;
    tok0 = (chain >> 2) * 2048; nchunks = 32; nvalid = 64; s0 = nullptr; ubase = chain * 32;
    sout = p.out() + O_PGDN + (size_t)chain * 16384;
  } else {
    const int j2 = job - 128, chain = j2 >> 2;
    vs = j2 & 3; h = chain & 3;
    tok0 = T_P + (chain >> 2); nchunks = 1; nvalid = 1; ubase = 1024 + chain;
    s0 = p.in(I_ST_GDN) + (size_t)chain * 16384;
    sout = p.out() + O_SGDN + (size_t)chain * 16384;
  }
  const gu16* QKV = (const gu16*)(p.ws() + WS_QKV);
  const gf32* SC = (const gf32*)(p.ws() + WS_SC);
  const gu16* AWS = (const gu16*)(p.ws() + WS_R1 + R1_AWS);
  const gu16* ATW = (const gu16*)(p.ws() + WS_R1 + R1_ATT);
  gf32* OGD = (gf32*)(p.ws() + WS_R1 + R1_OGD);
  u16* Kn = (u16*)smem;
  u16* Qn = Kn + 64 * 136;
  u16* ST = Qn + 64 * 136;
  u16* Am = ST + 32 * 136;
  u16* ATT = Am + 64 * 72;
  u16* rhsT = ATT + 64 * 72;
  u16* uT = rhsT + 32 * 72;
  u16* uwT = uT + 32 * 72;
  float* cum = (float*)(uwT + 32 * 72);
  float* beta = cum + 64;
  __syncthreads();
  f32x16 accS = zero16();
  {
    const int k = wave * 32 + (lane & 31);
#pragma unroll
    for (int r = 0; r < 16; ++r) {
      const int v = TROW(r, lane);
      if (s0) accS[r] = s0[(size_t)k * 128 + vs * 32 + v];
      ST[v * 136 + k] = f2bf(accS[r]);
    }
  }
  const int vj = tid >> 2, vq = (tid & 3) * 8;
  uint4 pq0, pq1, pq2, pq3, pk0, pk1, pk2, pk3, pa0, pa1, pt0, pt1, pv;
  float pbeta = 0.f, pg = 0.f;
  const uint4 z4 = make_uint4(0, 0, 0, 0);
#define GDN_LD1(dst, m_, off_) { const int idx_ = tid + 256 * (m_); const int i_ = idx_ >> 4; \
    dst = (i_ < nvalid) ? gld16(QKV + (r0_ + i_) * 1536 + (off_) + h * 128 + (idx_ & 15) * 8) : z4; }
#define GDN_LOAD(c_)                                                                     \
  {                                                                                      \
    const size_t r0_ = (size_t)tok0 + (size_t)(c_) * 64;                                 \
    const size_t u_ = (size_t)ubase + (c_);                                              \
    GDN_LD1(pq0, 0, 0) GDN_LD1(pq1, 1, 0) GDN_LD1(pq2, 2, 0) GDN_LD1(pq3, 3, 0)          \
    GDN_LD1(pk0, 0, 512) GDN_LD1(pk1, 1, 512) GDN_LD1(pk2, 2, 512) GDN_LD1(pk3, 3, 512)  \
    pa0 = gld16(AWS + u_ * 4096 + (size_t)tid * 8); pa1 = gld16(AWS + u_ * 4096 + (size_t)(tid + 256) * 8); \
    pt0 = gld16(ATW + u_ * 4096 + (size_t)tid * 8); pt1 = gld16(ATW + u_ * 4096 + (size_t)(tid + 256) * 8); \
    pv = (vj < nvalid) ? gld16(QKV + (r0_ + vj) * 1536 + 1024 + h * 128 + vs * 32 + vq) : z4; \
    if (tid < 64) {                                                                      \
      const bool ok_ = tid < nvalid;                                                     \
      pbeta = ok_ ? SC[(r0_ + tid) * 16 + 8 + h] : 0.f;                                  \
      pg = ok_ ? SC[(r0_ + tid) * 16 + 12 + h] : 0.f;                                    \
    }                                                                                    \
  }
#define LDS_ST72(base, m_, v_) { const int idx_ = tid + 256 * (m_); *(uint4*)((base) + (idx_ >> 3) * 72 + (idx_ & 7) * 8) = (v_); }
  GDN_LOAD(0)
  for (int c = 0; c < nchunks; ++c) {
    const size_t row0 = (size_t)tok0 + (size_t)c * 64;
    __syncthreads();
    LDS_ST136(Qn, 0, pq0) LDS_ST136(Qn, 1, pq1) LDS_ST136(Qn, 2, pq2) LDS_ST136(Qn, 3, pq3)
    LDS_ST136(Kn, 0, pk0) LDS_ST136(Kn, 1, pk1) LDS_ST136(Kn, 2, pk2) LDS_ST136(Kn, 3, pk3)
    LDS_ST72(Am, 0, pa0) LDS_ST72(Am, 1, pa1) LDS_ST72(ATT, 0, pt0) LDS_ST72(ATT, 1, pt1)
    rhsT[(vq + 0) * 72 + vj] = (u16)(pv.x & 0xffffu); rhsT[(vq + 1) * 72 + vj] = (u16)(pv.x >> 16);
    rhsT[(vq + 2) * 72 + vj] = (u16)(pv.y & 0xffffu); rhsT[(vq + 3) * 72 + vj] = (u16)(pv.y >> 16);
    rhsT[(vq + 4) * 72 + vj] = (u16)(pv.z & 0xffffu); rhsT[(vq + 5) * 72 + vj] = (u16)(pv.z >> 16);
    rhsT[(vq + 6) * 72 + vj] = (u16)(pv.w & 0xffffu); rhsT[(vq + 7) * 72 + vj] = (u16)(pv.w >> 16);
    if (tid < 64) { beta[tid] = pbeta; cum[tid] = wave_scan(pg, lane); }
    __syncthreads();
    if (c + 1 < nchunks) GDN_LOAD(c + 1)
    const float last = cum[63];
    f32x16 accQ = zero16();
    if (wave < 2) {
      const int mi = wave;
      f32x16 acc = zero16();
      mma_tile(acc, Kn + mi * 32 * 136, 136, ST, 136, 128, lane);
      const int v = lane & 31;
      float vv[16], bj[16], cj[16];
#pragma unroll
      for (int r = 0; r < 16; ++r) {
        const int j = mi * 32 + TROW(r, lane);
        vv[r] = bf2f(rhsT[v * 72 + j]); bj[r] = beta[j]; cj[r] = cum[j];
      }
#pragma unroll
      for (int r = 0; r < 16; ++r) {
        const int j = mi * 32 + TROW(r, lane);
        rhsT[v * 72 + j] = f2bf(bj[r] * (vv[r] - __expf(cj[r]) * acc[r]));
      }
    } else {
      mma_tile(accQ, Qn + (wave - 2) * 32 * 136, 136, ST, 136, 128, lane);
    }
    __syncthreads();
    if (wave < 2) {
      const int mi = wave;
      f32x16 acc = zero16();
      mma_tile(acc, Am + mi * 32 * 72, 72, rhsT, 72, 64, lane);
      const int v = lane & 31;
      float ci[16];
#pragma unroll
      for (int r = 0; r < 16; ++r) ci[r] = cum[mi * 32 + TROW(r, lane)];
#pragma unroll
      for (int r = 0; r < 16; ++r) {
        const int i = mi * 32 + TROW(r, lane);
        uT[v * 72 + i] = f2bf(acc[r]);
        uwT[v * 72 + i] = f2bf(acc[r] * __expf(last - ci[r]));
      }
    }
    __syncthreads();
    if (wave >= 2) {
      const int mi = wave - 2;
      f32x16 acc = zero16();
      mma_tile(acc, ATT + mi * 32 * 72, 72, uT, 72, 64, lane);
      const int v = lane & 31;
#pragma unroll
      for (int r = 0; r < 16; ++r) {
        const int i = mi * 32 + TROW(r, lane);
        if (i < nvalid) OGD[(row0 + i) * 512 + h * 128 + vs * 32 + v] = acc[r] + __expf(cum[i]) * accQ[r];
      }
    }
    {
      const float el = __expf(last);
#pragma unroll
      for (int r = 0; r < 16; ++r) accS[r] *= el;
      mma_tile_bg(accS, uwT, 72, Kn + wave * 32, 136, 64, lane);
      const int k = wave * 32 + (lane & 31);
#pragma unroll
      for (int r = 0; r < 16; ++r) ST[TROW(r, lane) * 136 + k] = f2bf(accS[r]);
    }
  }
#undef GDN_LOAD
#undef GDN_LD1
  {
    const int k = wave * 32 + (lane & 31);
#pragma unroll
    for (int r = 0; r < 16; ++r) sout[(size_t)k * 128 + vs * 32 + TROW(r, lane)] = accS[r];
  }
}

__device__ __forceinline__ void postab_phase(const Params& p) {
  const int tid = opaque_tid(), lane = tid & 63;
  const int wg = blockIdx.x * 4 + (tid >> 6), nw = gridDim.x * 4;
  const gu16* Pab = (const gu16*)(p.ws() + WS_R1 + R1_PAB);
  const gf32* OG = (const gf32*)(p.ws() + WS_R1 + R1_OG);
  gu16* C0 = (gu16*)(p.ws() + WS_HC);
  float4 gg[2];
#pragma unroll
  for (int m = 0; m < 2; ++m) gg[m] = gldf4(p.in(I_G_GLA_NORM) + ((m * 256 + lane * 4) & 127));
  for (int row0 = wg; row0 < T_ALL; row0 += 2 * nw) {
    float4 o[2][2], r[2][2];
    bool ok[2];
#pragma unroll
    for (int u = 0; u < 2; ++u) {
      const int row = row0 + u * nw;
      ok[u] = row < T_ALL;
#pragma unroll
      for (int m = 0; m < 2; ++m) {
        const int c = m * 256 + lane * 4;
        if (ok[u]) { o[u][m] = gldf4(OG + (size_t)row * 512 + c); r[u][m] = ld_bf4(Pab + (size_t)row * N_AB + 1024 + c); }
        else { o[u][m] = make_float4(0.f, 0.f, 0.f, 0.f); r[u][m] = o[u][m]; }
      }
    }
#pragma unroll
    for (int u = 0; u < 2; ++u) {
      const int row = row0 + u * nw;
#pragma unroll
      for (int m = 0; m < 2; ++m) {
        const int c = m * 256 + lane * 4;
        const float4 ov = o[u][m], rv = r[u][m];
        const float ss = half_sum(ov.x * ov.x + ov.y * ov.y + ov.z * ov.z + ov.w * ov.w);
        const float rstd = rsqrtf(ss * (1.f / 128.f) + 1e-6f);
        if (ok[u])
          st_bf4(C0 + (size_t)row * 1024 + c, ov.x * rstd * gg[m].x * siluf_(rv.x), ov.y * rstd * gg[m].y * siluf_(rv.y),
                 ov.z * rstd * gg[m].z * siluf_(rv.z), ov.w * rstd * gg[m].w * siluf_(rv.w));
      }
    }
  }
}

__device__ __forceinline__ float cd_scalar(const Params& p, const gu16* PZG, size_t row, int sc) {
  const float raw = bf2f(PZG[row * 1040 + 1024 + sc]);
  if (sc < 8) return softplusf_(raw + p.in(I_SSD_DT_BIAS)[sc]);
  if (sc < 12) return sigmoidf_(raw);
  return -expf(p.in(I_GDN_A_LOG)[sc - 12]) * softplusf_(raw + p.in(I_GDN_DT_BIAS)[sc - 12]);
}
__device__ __forceinline__ void precd_phase(const Params& p) {
  const int tid = opaque_tid(), lane = tid & 63;
  const int wg = blockIdx.x * 4 + (tid >> 6), nw = gridDim.x * 4;
  const gu16* PX = (const gu16*)(p.ws() + WS_R1 + R1_PX);
  const gu16* PZG = (const gu16*)(p.ws() + WS_R1 + R1_PZG);
  gu16* XBC = (gu16*)(p.ws() + WS_HC);
  gu16* QKV = (gu16*)(p.ws() + WS_QKV);
  gf32* SC = (gf32*)(p.ws() + WS_SC);
  constexpr int NPU = 8 * 64 * 11, NSU = 128 * 10 + 1;
  for (int unit = wg; unit < NPU + NSU; unit += nw) {
    if (unit < NPU) {
      const int m = unit % 11, rr = unit / 11, t0 = (rr & 63) * 32, b = rr >> 6;
      const size_t rowbase = (size_t)b * 2048;
      if (m == 10) {
#pragma unroll
        for (int k = 0; k < 8; ++k) {
          const int v = lane + 64 * k;
          const size_t row = rowbase + t0 + (v >> 4);
          SC[row * 16 + (v & 15)] = cd_scalar(p, PZG, row, v & 15);
        }
      } else {
        const int cc = m * 256 + lane * 4;
        const bool isx = m < 4;
        const int cw = isx ? cc : cc - 1024;
        const int CW = isx ? 1024 : 1536;
        const gf32* wt = isx ? p.in(I_SSD_CONV_W) : p.in(I_GDN_CONV_W);
        const float4 w0 = gldf4(wt + cw), w1 = gldf4(wt + CW + cw), w2 = gldf4(wt + 2 * CW + cw), w3 = gldf4(wt + 3 * CW + cw);
        float4 bb = make_float4(0.f, 0.f, 0.f, 0.f);
        if (isx) bb = gldf4(p.in(I_SSD_CONV_B) + cw);
        const float4 zz = make_float4(0.f, 0.f, 0.f, 0.f);
        float4 x0 = zz, x1 = zz, x2 = zz;
        if (t0 > 0) {
          x0 = ld_bf4(PX + (rowbase + t0 - 3) * 2560 + cc);
          x1 = ld_bf4(PX + (rowbase + t0 - 2) * 2560 + cc);
          x2 = ld_bf4(PX + (rowbase + t0 - 1) * 2560 + cc);
        }
        const float qsc = (m < 6) ? 0.08838834764831845f : 1.f;
        gf32* cso = p.out() + (isx ? O_PSSDC : O_PGDNC) + (size_t)b * 3 * CW + cw;
#pragma unroll 1
        for (int tb = t0; tb < t0 + 32; tb += 16) {
          float4 xs[16];
#pragma unroll
          for (int u = 0; u < 16; ++u) xs[u] = ld_bf4(PX + (rowbase + tb + u) * 2560 + cc);
#pragma unroll
          for (int u = 0; u < 16; ++u) {
            const int t = tb + u;
            const size_t row = rowbase + t;
            const float4 x3 = xs[u];
            const float a0 = x0.x * w0.x + x1.x * w1.x + x2.x * w2.x + x3.x * w3.x + bb.x;
            const float a1 = x0.y * w0.y + x1.y * w1.y + x2.y * w2.y + x3.y * w3.y + bb.y;
            const float a2 = x0.z * w0.z + x1.z * w1.z + x2.z * w2.z + x3.z * w3.z + bb.z;
            const float a3 = x0.w * w0.w + x1.w * w1.w + x2.w * w2.w + x3.w * w3.w + bb.w;
            float v0 = siluf_(a0), v1 = siluf_(a1), v2 = siluf_(a2), v3 = siluf_(a3);
            if (isx) {
              st_bf4(XBC + row * 1024 + cc, v0, v1, v2, v3);
            } else {
              if (m < 8) {
                const float ss = half_sum(v0 * v0 + v1 * v1 + v2 * v2 + v3 * v3);
                const float sc = rsqrtf(ss + 1e-6f) * qsc;
                v0 *= sc; v1 *= sc; v2 *= sc; v3 *= sc;
              }
              st_bf4(QKV + row * 1536 + cw, v0, v1, v2, v3);
            }
            if (t >= 2045) gstf4(cso + (size_t)(t - 2045) * CW, x3);
            x0 = x1; x1 = x2; x2 = x3;
          }
        }
      }
    } else {
      const int su = unit - NPU;
      if (su == 1280) {
#pragma unroll 4
        for (int k = 0; k < 32; ++k) {
          const int v = lane + 64 * k;
          const size_t row = (size_t)T_P + (v >> 4);
          SC[row * 16 + (v & 15)] = cd_scalar(p, PZG, row, v & 15);
        }
      } else {
        const int s = su / 10, m = su % 10;
        const size_t row = (size_t)T_P + s;
        const int cc = m * 256 + lane * 4;
        const bool isx = m < 4;
        const int cw = isx ? cc : cc - 1024;
        const int CW = isx ? 1024 : 1536;
        const gf32* wt = isx ? p.in(I_SSD_CONV_W) : p.in(I_GDN_CONV_W);
        const gf32* sb = (isx ? p.in(I_ST_SSDC) : p.in(I_ST_GDNC)) + (size_t)s * 3 * CW + cw;
        gf32* so = p.out() + (isx ? O_SSSDC : O_SGDNC) + (size_t)s * 3 * CW + cw;
        const float4 x0 = gldf4(sb), x1 = gldf4(sb + CW), x2 = gldf4(sb + 2 * CW);
        const float4 x3 = ld_bf4(PX + row * 2560 + cc);
        const float4 w0 = gldf4(wt + cw), w1 = gldf4(wt + CW + cw), w2 = gldf4(wt + 2 * CW + cw), w3 = gldf4(wt + 3 * CW + cw);
        float4 bb = make_float4(0.f, 0.f, 0.f, 0.f);
        if (isx) bb = gldf4(p.in(I_SSD_CONV_B) + cw);
        gstf4(so, x1); gstf4(so + CW, x2); gstf4(so + 2 * CW, x3);
        const float a0 = x0.x * w0.x + x1.x * w1.x + x2.x * w2.x + x3.x * w3.x + bb.x;
        const float a1 = x0.y * w0.y + x1.y * w1.y + x2.y * w2.y + x3.y * w3.y + bb.y;
        const float a2 = x0.z * w0.z + x1.z * w1.z + x2.z * w2.z + x3.z * w3.z + bb.z;
        const float a3 = x0.w * w0.w + x1.w * w1.w + x2.w * w2.w + x3.w * w3.w + bb.w;
        float v0 = siluf_(a0), v1 = siluf_(a1), v2 = siluf_(a2), v3 = siluf_(a3);
        if (isx) {
          st_bf4(XBC + row * 1024 + cc, v0, v1, v2, v3);
        } else {
          if (m < 8) {
            const float ss = half_sum(v0 * v0 + v1 * v1 + v2 * v2 + v3 * v3);
            const float sc = rsqrtf(ss + 1e-6f) * ((m < 6) ? 0.08838834764831845f : 1.f);
            v0 *= sc; v1 *= sc; v2 *= sc; v3 *= sc;
          }
          st_bf4(QKV + row * 1536 + cw, v0, v1, v2, v3);
        }
      }
    }
  }
}

__device__ __forceinline__ void postcd_phase(const Params& p) {
  const int tid = opaque_tid(), lane = tid & 63;
  const int wg = blockIdx.x * 4 + (tid >> 6), nw = gridDim.x * 4;
  const gu16* PZG = (const gu16*)(p.ws() + WS_R1 + R1_PZG);
  const gf32* YS = (const gf32*)(p.ws() + WS_R1 + R1_YS);
  const gf32* OGD = (const gf32*)(p.ws() + WS_R1 + R1_OGD);
  gu16* HC = (gu16*)(p.ws() + WS_HC);
  for (int row = wg; row < T_ALL; row += nw) {
    float4 val[4];
#pragma unroll
    for (int m = 0; m < 2; ++m) {
      const int c = m * 256 + lane * 4;
      const float4 y = gldf4(YS + (size_t)row * 512 + c);
      const float4 xs = ld_bf4(HC + (size_t)row * 1024 + c);
      const float4 z = ld_bf4(PZG + (size_t)row * 1040 + c);
      const float dd = p.in(I_SSD_D)[c >> 6];
      float4 v = make_float4((y.x + dd * xs.x) * siluf_(z.x), (y.y + dd * xs.y) * siluf_(z.y),
                             (y.z + dd * xs.z) * siluf_(z.z), (y.w + dd * xs.w) * siluf_(z.w));
      const float ss = wave_sum(v.x * v.x + v.y * v.y + v.z * v.z + v.w * v.w);
      const float rstd = rsqrtf(ss * (1.f / 256.f) + 1e-6f);
      const float4 gg = gldf4(p.in(I_SSD_NORM) + c);
      val[m] = make_float4(v.x * rstd * gg.x, v.y * rstd * gg.y, v.z * rstd * gg.z, v.w * rstd * gg.w);
    }
#pragma unroll
    for (int m = 0; m < 2; ++m) {
      const int c = m * 256 + lane * 4;
      const float4 o = gldf4(OGD + (size_t)row * 512 + c);
      const float ss = half_sum(o.x * o.x + o.y * o.y + o.z * o.z + o.w * o.w);
      const float rstd = rsqrtf(ss * (1.f / 128.f) + 1e-6f);
      const float4 gg = gldf4(p.in(I_GDN_NORM) + (c & 127));
      const float4 gt = ld_bf4(PZG + (size_t)row * 1040 + 512 + c);
      val[2 + m] = make_float4(o.x * rstd * gg.x * siluf_(gt.x), o.y * rstd * gg.y * siluf_(gt.y),
                               o.z * rstd * gg.z * siluf_(gt.z), o.w * rstd * gg.w * siluf_(gt.w));
    }
#pragma unroll
    for (int m = 0; m < 4; ++m)
      st_bf4(HC + (size_t)row * 1024 + m * 256 + lane * 4, val[m].x, val[m].y, val[m].z, val[m].w);
  }
}


#define XB_TMO      128
#define XB_XCNT(j)  (256  + 64 * (j))
#define XB_XSUB(j)  (1280 + 64 * (j))
#define XB_XGEN(j)  (2304 + 64 * (j))
#define XB_TOP      3328
#define XB_TOPGEN   3392
#define XCD_BAR_WORDS 3456
#define XB_SPIN_CAP (1u << 18)
#define LAS __attribute__((address_space(3)))
__device__ __forceinline__ unsigned xb_ld(guint* p) { return __hip_atomic_load(p, __ATOMIC_RELAXED, __HIP_MEMORY_SCOPE_AGENT); }
__device__ __forceinline__ unsigned xb_add(guint* p, unsigned v) { return __hip_atomic_fetch_add(p, v, __ATOMIC_RELAXED, __HIP_MEMORY_SCOPE_AGENT); }
__device__ __forceinline__ unsigned xb_xcc_id() { return (unsigned)__builtin_amdgcn_s_getreg((3 << 11) | 20) & 0xFu; }
#define XB_SPIN(cond, bar) do { unsigned _sp = 0; while (cond) { __builtin_amdgcn_s_sleep(1); \
    if ((++_sp & 255u) == 0u) { if (xb_ld(&(bar)[XB_TMO])) break; if (_sp > XB_SPIN_CAP) { (void)xb_add(&(bar)[XB_TMO], 1u); break; } } } } while (0)
struct XcdBarrier { guint* bar; unsigned x; volatile LAS unsigned* st; };
__device__ __forceinline__ XcdBarrier xcd_barrier_post(guint* bar, volatile LAS unsigned* st) {
  XcdBarrier b; b.bar = bar; b.x = xb_xcc_id(); b.st = st;
  if (threadIdx.x == 0) (void)xb_add(&bar[XB_XCNT(b.x)], 1u);
  return b;
}
__device__ __forceinline__ void xcd_barrier_complete(guint* bar, unsigned x, unsigned& nloc, unsigned& nx) {
  const unsigned G = gridDim.x * gridDim.y * gridDim.z;
  unsigned sum, cnt, mine, sp = 0u;
  for (;;) {
    sum = 0u; cnt = 0u; mine = 0u;
#pragma unroll
    for (unsigned j = 0; j < 16; ++j) { const unsigned c = xb_ld(&bar[XB_XCNT(j)]); sum += c; cnt += (c > 0u) ? 1u : 0u; mine = (j == x) ? c : mine; }
    if (sum == G) break;
    __builtin_amdgcn_s_sleep(1);
    if ((++sp & 255u) == 0u) { if (xb_ld(&bar[XB_TMO])) break; if (sp > XB_SPIN_CAP) { (void)xb_add(&bar[XB_TMO], 1u); break; } }
  }
  nloc = mine > 0u ? mine : 1u; nx = cnt > 0u ? cnt : 1u;
}
__device__ __forceinline__ void xcd_barrier(const XcdBarrier& b) {
  asm volatile("s_waitcnt vmcnt(0)" ::: "memory");
  __syncthreads();
  if (threadIdx.x == 0) {
    guint* bar = b.bar;
    __builtin_amdgcn_s_waitcnt(0);
    unsigned nloc = b.st[0], nx = b.st[1];
    if (nloc == 0u) { xcd_barrier_complete(bar, b.x, nloc, nx); b.st[0] = nloc; b.st[1] = nx; }
    const unsigned old = xb_add(&bar[XB_XSUB(b.x)], 1u);
    const unsigned gen = old / nloc;
    if (old + 1u == (gen + 1u) * nloc) {
      __builtin_amdgcn_fence(__ATOMIC_RELEASE, "agent");
      asm volatile("s_waitcnt vmcnt(0)" ::: "memory");
      const unsigned og = xb_add(&bar[XB_TOP], 1u);
      const unsigned tg = og / nx;
      if (og + 1u == (tg + 1u) * nx) xb_add(&bar[XB_TOPGEN], 1u);
      else XB_SPIN(xb_ld(&bar[XB_TOPGEN]) == tg, bar);
      __builtin_amdgcn_fence(__ATOMIC_ACQUIRE, "agent");
      xb_add(&bar[XB_XGEN(b.x)], 1u);
      asm volatile("s_waitcnt vmcnt(0)" ::: "memory");
    } else {
      XB_SPIN(xb_ld(&bar[XB_XGEN(b.x)]) == gen, bar);
      __builtin_amdgcn_fence(__ATOMIC_ACQUIRE, "agent");
      asm volatile("s_waitcnt vmcnt(0)" ::: "memory");
    }
  }
  __syncthreads();
}

constexpr int N_PHASES = 20;

template <int ph>
__device__ __forceinline__ void run_phase(const Params& p, char* smem) {
  gchar* W = p.ws() + WS_W;
  gu16* HC = (gu16*)(p.ws() + WS_HC);
  gchar* R1 = p.ws() + WS_R1;
  Epi e{};
  e.x0 = p.in(I_XP); e.x1 = p.in(I_XS); e.of = p.out();
  switch (ph) {
    case 0:
      convert_weight(p.in(I_W_IN_AB), 1024, 2064, (gu16*)(W + W_INAB), N_AB, 1, smem);
      norm_phase(p, 0, p.in(I_NORM_MIX), 0);
      break;
    case 1:
      e.ob = (gu16*)(R1 + R1_PAB);
      gemm_phase_xcd<EPI_INAB>(HC, 1024, (const gu16*)(W + W_INAB), 1024, N_AB / 128, e, smem);
      break;
    case 2:
      for (;;) {
        const int job = q_next(p, 0, smem);
        if (job >= 1856 + 2368) break;
        if (job >= 1856) convert_filler(p, 0, job - 1856, smem);
        else if (job >= 256 && job < 1792) gla_prep_unit(p, job - 256, smem);
        else s5_unit(p, job < 256 ? job : job - 1536, smem);
      }
      break;
    case 3:
      e.ob = HC; e.yb = (const gu16*)(R1 + R1_YBF); e.bias = p.in(I_B_S5_GLU);
      for (;;) {
        const int job = q_next(p, 3, smem);
        if (job >= 2692) break;
        if (job >= 128 && job < 644) gemm_tile<EPI_GLU>((const gu16*)(R1 + R1_YBF), 512, (const gu16*)(W + W_GLU), 512, 4, e, smem, job - 128);
        else gla_seq_unit(p, job < 128 ? job : job - 516, smem);
      }
      break;
    case 4:
      postab_phase(p);
      break;
    case 5:
      gemm_res_phase<EPI_RES0>(HC, 1024, (const gu16*)(W + W_OUTAB), 1024, e, (gf32*)(p.ws() + WS_SLAB), smem);
      break;
    case 6:
      norm_phase(p, 1, p.in(I_NORM_MLP), 2);
      break;
    case 7:
      e.ob = (gu16*)R1;
      gemm_phase<EPI_UP>(HC, 1024, (const gu16*)(W + W_UP0), 1024, 32, e, smem);
      break;
    case 8:
      gemm_res_phase<EPI_RES>((const gu16*)R1, 4096, (const gu16*)(W + W_DOWN0), 4096, e, (gf32*)(p.ws() + WS_SLAB), smem);
      break;
    case 9:
      norm_phase(p, 1, p.in(I_NORM_MIX) + 1024, 1);
      convert_weight(p.in(I_W_IN_CD), 1024, 3600, (gu16*)(W + W_INCD), N_CD, 2, smem);
      break;
    case 10:
      e.ob = (gu16*)(R1 + R1_PX); e.ob2 = (gu16*)(R1 + R1_PZG);
      gemm_phase_xcd<EPI_INCD>(HC, 1024, (const gu16*)(W + W_INCD), 1024, N_CD / 128, e, smem);
      break;
    case 11:
      precd_phase(p);
      break;
    case 12:
      for (;;) {
        const int job = q_next(p, 1, smem);
        if (job >= 3584 + 2304) break;
        if (job >= 3584) convert_filler(p, 1, job - 3584, smem);
        else if (job < 1536) gdn_prep_unit(p, job, smem);
        else ssd_unit(p, job - 1536 + 128, smem);
      }
      break;
    case 13:
      for (;;) {
        const int job = q_next(p, 2, smem);
        if (job >= 2304) break;
        if (job >= 128 && job < 256) ssd_unit(p, job - 128, smem);
        else gdn_unit(p, job < 128 ? job : job - 128, smem);
      }
      break;
    case 14:
      postcd_phase(p);
      break;
    case 15:
      gemm_res_phase<EPI_RES>(HC, 1024, (const gu16*)(W + W_OUTCD), 1024, e, (gf32*)(p.ws() + WS_SLAB), smem);
      break;
    case 16:
      norm_phase(p, 1, p.in(I_NORM_MLP) + 1024, 1);
      break;
    case 17:
      e.ob = (gu16*)R1;
      gemm_phase<EPI_UP>(HC, 1024, (const gu16*)(W + W_UP1), 1024, 32, e, smem);
      break;
    case 18:
      gemm_res_phase<EPI_RES>((const gu16*)R1, 4096, (const gu16*)(W + W_DOWN1), 4096, e, (gf32*)(p.ws() + WS_SLAB), smem);
      break;
    case 19:
      norm_phase(p, 2, p.in(I_NORM_FINAL), 1);
      break;
    default: break;
  }
}

__global__ void __launch_bounds__(256, 2) hybrid_fwd(Params p) {
  extern __shared__ __attribute__((aligned(16))) char smem[];
  cg::grid_group grid = cg::this_grid();
  Params* lp = (Params*)(smem + LP_OFF);
  volatile LAS unsigned* xst = (volatile LAS unsigned*)(smem + XB_ST_OFF);
  if (threadIdx.x == 0) { *lp = p; xst[0] = 0u; xst[1] = 0u; }
  __syncthreads();
  if (p.ph_lo < 0) grid.sync();
  XcdBarrier xb;
  xb.bar = (guint*)(p.ws() + WS_BAR); xb.x = 0; xb.st = xst;
  if (p.ph_hi - p.ph_lo > 1) xb = xcd_barrier_post((guint*)(p.ws() + WS_BAR), xst);
#define PHASE(n)                                   \
  if (p.ph_lo <= (n) && (n) < p.ph_hi) {           \
    run_phase<(n)>(*lp, smem);                     \
    if ((n) + 1 < p.ph_hi) xcd_barrier(xb);        \
  }
  PHASE(0) PHASE(1) PHASE(2) PHASE(3) PHASE(4) PHASE(5) PHASE(6) PHASE(7) PHASE(8) PHASE(9)
  PHASE(10) PHASE(11) PHASE(12) PHASE(13) PHASE(14) PHASE(15) PHASE(16) PHASE(17) PHASE(18) PHASE(19)
}

extern "C" void kernel_launch(void* const* d_in, const int* in_sizes, int n_in, void* d_out, int out_size, void* d_ws,
                              size_t ws_size, hipStream_t stream) {
  static int grid_blocks = 0;
  if (grid_blocks == 0) {
    if (n_in != N_INPUTS || (size_t)out_size != O_END || ws_size < WS_END) {
      fprintf(stderr, "kernel_launch: unexpected sizes n_in %d out %d ws %zu (need %zu)\n", n_in, out_size, ws_size,
              (size_t)WS_END);
      grid_blocks = -1;
      return;
    }
    int dev = 0, cus = 0, per_cu = 0;
    (void)hipGetDevice(&dev);
    (void)hipDeviceGetAttribute(&cus, hipDeviceAttributeMultiprocessorCount, dev);
    if (hipFuncSetAttribute((const void*)hybrid_fwd, hipFuncAttributeMaxDynamicSharedMemorySize, LDS_BYTES) != hipSuccess) {
      fprintf(stderr, "kernel_launch: hipFuncSetAttribute failed\n");
      grid_blocks = -1;
      return;
    }
    if (hipOccupancyMaxActiveBlocksPerMultiprocessor(&per_cu, (const void*)hybrid_fwd, 256, LDS_BYTES) != hipSuccess || per_cu < 1) {
      fprintf(stderr, "kernel_launch: occupancy query failed (%d)\n", per_cu);
      (void)hipGetLastError();
      per_cu = 1;
    }
    if (per_cu > 2) per_cu = 2;
    grid_blocks = cus * per_cu;
  }
  if (grid_blocks < 0) return;
  (void)hipMemsetAsync((char*)d_ws + WS_CTR, 0, 256 + 16384, stream);
  Params p{};
  for (int i = 0; i < N_INPUTS; ++i) p.in_[i] = (const float*)d_in[i];
  p.out_ = (float*)d_out;
  p.ws_ = (char*)d_ws;
#if MULTI_LAUNCH
  for (int ph = 0; ph < N_PHASES; ++ph) {
    p.ph_lo = ph; p.ph_hi = ph + 1;
    hipLaunchKernelGGL(hybrid_fwd, dim3(grid_blocks), dim3(256), LDS_BYTES, stream, p);
#ifdef PROBE_DUP
    if ((PROBE_DUP >> ph) & 1) {
      (void)hipMemsetAsync((char*)d_ws + WS_CTR, 0, 256, stream);
      hipLaunchKernelGGL(hybrid_fwd, dim3(grid_blocks), dim3(256), LDS_BYTES, stream, p);
    }
#endif
  }
#else
  p.ph_lo = 0; p.ph_hi = N_PHASES;
  void* args[] = {&p};
  hipError_t err = hipLaunchCooperativeKernel((const void*)hybrid_fwd, dim3(grid_blocks), dim3(256), args, LDS_BYTES, stream);
  if (err != hipSuccess) fprintf(stderr, "cooperative launch failed: %s (grid %d)\n", hipGetErrorString(err), grid_blocks);
#endif
}
```

```cpp
#include <hip/hip_runtime.h>
#include <hip/hip_cooperative_groups.h>
#include <cstdio>
#include <cstdint>
namespace cg = cooperative_groups;

#ifndef MULTI_LAUNCH
#define MULTI_LAUNCH 0
#endif

typedef unsigned short u16;
typedef __attribute__((ext_vector_type(8))) short bf16x8;
typedef __attribute__((ext_vector_type(16))) float f32x16;

constexpr int T_ALL = 16512;
constexpr int T_P = 16384;
constexpr int N_AB = 2176;
constexpr int N_CD = 3712;
constexpr int LDS_BYTES = 77824;
constexpr int SJ_OFF = 77808;
constexpr int LP_OFF = 77440;
constexpr int XB_ST_OFF = 77792;

enum { I_XP = 0, I_XS, I_ST_GLA, I_ST_S5RE, I_ST_S5IM, I_ST_SSD, I_ST_SSDC, I_ST_GDN, I_ST_GDNC, I_NORM_MIX, I_NORM_MLP,
       I_NORM_FINAL, I_W_UP, I_W_DOWN, I_W_IN_AB, I_W_OUT_AB, I_W_GLA_GATE, I_B_GLA_GATE, I_G_GLA_NORM, I_S5_LAM_RE,
       I_S5_LAM_IM, I_S5_B_RE, I_S5_B_IM, I_S5_C_RE, I_S5_C_IM, I_S5_D, I_S5_LOG_DT, I_W_S5_GLU, I_B_S5_GLU, I_W_IN_CD,
       I_W_OUT_CD, I_SSD_CONV_W, I_SSD_CONV_B, I_SSD_DT_BIAS, I_SSD_A_LOG, I_SSD_D, I_SSD_NORM, I_GDN_CONV_W,
       I_GDN_A_LOG, I_GDN_DT_BIAS, I_GDN_NORM, N_INPUTS };

constexpr size_t O_Y = 0;
constexpr size_t O_PGLA = (size_t)T_ALL * 1024;
constexpr size_t O_PS5RE = O_PGLA + 8 * 4 * 64 * 128;
constexpr size_t O_PS5IM = O_PS5RE + 8 * 32 * 64;
constexpr size_t O_PSSD = O_PS5IM + 8 * 32 * 64;
constexpr size_t O_PSSDC = O_PSSD + 8 * 8 * 64 * 128;
constexpr size_t O_PGDN = O_PSSDC + 8 * 3 * 1024;
constexpr size_t O_PGDNC = O_PGDN + 8 * 4 * 128 * 128;
constexpr size_t O_SGLA = O_PGDNC + 8 * 3 * 1536;
constexpr size_t O_SS5RE = O_SGLA + (size_t)128 * 4 * 64 * 128;
constexpr size_t O_SS5IM = O_SS5RE + 128 * 32 * 64;
constexpr size_t O_SSSD = O_SS5IM + 128 * 32 * 64;
constexpr size_t O_SSSDC = O_SSSD + (size_t)128 * 8 * 64 * 128;
constexpr size_t O_SGDN = O_SSSDC + 128 * 3 * 1024;
constexpr size_t O_SGDNC = O_SGDN + (size_t)128 * 4 * 128 * 128;
constexpr size_t O_END = O_SGDNC + 128 * 3 * 1536;

constexpr size_t WS_W = 0;
constexpr size_t W_INAB = 0;
constexpr size_t W_GLU = W_INAB + (size_t)N_AB * 1024 * 2;
constexpr size_t W_OUTAB = W_GLU + 512 * 512 * 2;
constexpr size_t W_UP0 = W_OUTAB + 1024 * 1024 * 2;
constexpr size_t W_DOWN0 = W_UP0 + (size_t)4096 * 1024 * 2;
constexpr size_t W_INCD = 0;
constexpr size_t W_OUTCD = W_INCD + (size_t)N_CD * 1024 * 2;
constexpr size_t W_UP1 = W_OUTCD + 1024 * 1024 * 2;
constexpr size_t W_DOWN1 = W_UP1 + (size_t)4096 * 1024 * 2;
constexpr size_t WS_W_SIZE = W_DOWN1 + (size_t)4096 * 1024 * 2;
constexpr size_t WS_HC = WS_W + WS_W_SIZE;
constexpr size_t WS_R1 = WS_HC + (size_t)T_ALL * 1024 * 2;
constexpr size_t R1_SIZE = (size_t)T_ALL * 4096 * 2;
constexpr size_t R1_PAB = 0;
constexpr size_t R1_OG = R1_PAB + (size_t)T_ALL * N_AB * 2;
constexpr size_t R1_YBF = R1_OG + (size_t)T_ALL * 512 * 4;
constexpr size_t R1_PZG = 0;
constexpr size_t R1_PX = R1_PZG + (size_t)T_ALL * 1040 * 2;
constexpr size_t R1_YS = R1_PX;
constexpr size_t R1_OGD = R1_YS + (size_t)T_ALL * 512 * 4;
constexpr size_t R1_AWS = R1_OGD + (size_t)T_ALL * 512 * 4;
constexpr size_t R1_ATT = R1_AWS + (size_t)1536 * 4096 * 2;
static_assert(R1_ATT + (size_t)1536 * 4096 * 2 <= R1_SIZE, "R1 overflow");
static_assert(R1_YBF + (size_t)T_ALL * 512 * 2 <= R1_SIZE, "R1 overflow");
constexpr size_t WS_QKV = WS_R1 + R1_SIZE;
constexpr size_t WS_SC = WS_QKV + (size_t)T_ALL * 1536 * 2;
constexpr size_t WS_CTR = WS_SC + (size_t)T_ALL * 16 * 4;
constexpr size_t WS_BAR = WS_CTR + 256;
constexpr size_t WS_SLAB = WS_BAR + 16384;
constexpr size_t WS_END = WS_SLAB + (size_t)4 * 128 * 1024 * 4;

#define GLOBAL_AS __attribute__((address_space(1)))
typedef GLOBAL_AS float gf32;
typedef GLOBAL_AS u16 gu16;
typedef GLOBAL_AS char gchar;
typedef GLOBAL_AS unsigned guint;
typedef GLOBAL_AS uint4 guint4;
typedef GLOBAL_AS uint2 guint2;
typedef GLOBAL_AS float4 gfloat4;
struct Params {
  const float* in_[N_INPUTS];
  float* out_;
  char* ws_;
  int ph_lo, ph_hi;
  __device__ __forceinline__ const gf32* in(int i) const { return (const gf32*)in_[i]; }
  __device__ __forceinline__ gf32* out() const { return (gf32*)out_; }
  __device__ __forceinline__ gchar* ws() const { return (gchar*)ws_; }
};

typedef unsigned __attribute__((ext_vector_type(4))) u32x4_t;
typedef unsigned __attribute__((ext_vector_type(2))) u32x2_t;
typedef float __attribute__((ext_vector_type(4))) f32x4_t;
__device__ __forceinline__ uint4 gld16(const GLOBAL_AS void* p) { const u32x4_t v = *(const GLOBAL_AS u32x4_t*)p; return make_uint4(v.x, v.y, v.z, v.w); }
__device__ __forceinline__ void gst16(GLOBAL_AS void* p, uint4 v) { u32x4_t t; t.x = v.x; t.y = v.y; t.z = v.z; t.w = v.w; *(GLOBAL_AS u32x4_t*)p = t; }
__device__ __forceinline__ uint2 gld8(const GLOBAL_AS void* p) { const u32x2_t v = *(const GLOBAL_AS u32x2_t*)p; return make_uint2(v.x, v.y); }
__device__ __forceinline__ void gst8(GLOBAL_AS void* p, uint2 v) { u32x2_t t; t.x = v.x; t.y = v.y; *(GLOBAL_AS u32x2_t*)p = t; }
__device__ __forceinline__ float4 gldf4(const GLOBAL_AS void* p) { const f32x4_t v = *(const GLOBAL_AS f32x4_t*)p; return make_float4(v.x, v.y, v.z, v.w); }
__device__ __forceinline__ void gstf4(GLOBAL_AS void* p, float4 v) { f32x4_t t; t.x = v.x; t.y = v.y; t.z = v.z; t.w = v.w; *(GLOBAL_AS f32x4_t*)p = t; }
typedef __bf16 bf16v2_t __attribute__((ext_vector_type(2)));
__device__ __forceinline__ unsigned pack2(float a, float b) {
  bf16v2_t v;
  v.x = (__bf16)a;
  v.y = (__bf16)b;
  return __builtin_bit_cast(unsigned, v);
}
__device__ __forceinline__ unsigned pack2_hw(float a, float b) { return pack2(a, b); }
__device__ __forceinline__ u16 f2bf(float f) { return __builtin_bit_cast(u16, (__bf16)f); }
__device__ __forceinline__ float bf2f(u16 h) { return __uint_as_float(((unsigned)h) << 16); }
__device__ __forceinline__ float sigmoidf_(float x) { return 1.f / (1.f + __expf(-x)); }
__device__ __forceinline__ float siluf_(float x) { return x / (1.f + __expf(-x)); }
__device__ __forceinline__ float softplusf_(float x) { return fmaxf(x, 0.f) + __logf(1.f + __expf(-fabsf(x))); }
__device__ __forceinline__ float geluf_(float x) {
  float z = 0.7978845608f * (x + 0.044715f * x * x * x);
  float t = 1.f - 2.f / (__expf(2.f * z) + 1.f);
  return 0.5f * x * (1.f + t);
}
__device__ __forceinline__ float wave_sum(float v) {
#pragma unroll
  for (int d = 32; d >= 1; d >>= 1) v += __shfl_xor(v, d);
  return v;
}
__device__ __forceinline__ float half_sum(float v) {
#pragma unroll
  for (int d = 16; d >= 1; d >>= 1) v += __shfl_xor(v, d);
  return v;
}
__device__ __forceinline__ float wave_scan(float v, int lane) {
#pragma unroll
  for (int d = 1; d < 64; d <<= 1) {
    float t = __shfl_up(v, d);
    if (lane >= d) v += t;
  }
  return v;
}
__device__ __forceinline__ int opaque_tid() {
  int t = threadIdx.x;
  asm volatile("" : "+v"(t));
  return t;
}
#define TROW(r, lane) (((r) & 3) + 8 * ((r) >> 2) + 4 * ((lane) >> 5))

__device__ __forceinline__ void mma_tile(f32x16& acc, const u16* A, int lda, const u16* Bt, int ldb, int K, int lane) {
  const u16* ap = A + (lane & 31) * lda + 8 * (lane >> 5);
  const u16* bp = Bt + (lane & 31) * ldb + 8 * (lane >> 5);
#pragma unroll 4
  for (int k0 = 0; k0 < K; k0 += 16) {
    bf16x8 a = *(const bf16x8*)(ap + k0);
    bf16x8 b = *(const bf16x8*)(bp + k0);
    acc = __builtin_amdgcn_mfma_f32_32x32x16_bf16(a, b, acc, 0, 0, 0);
  }
}
__device__ __forceinline__ void mma_tile_bg(f32x16& acc, const u16* A, int lda, const u16* B, int ldb, int K, int lane) {
  const u16* ap = A + (lane & 31) * lda + 8 * (lane >> 5);
  const u16* bp = B + (8 * (lane >> 5)) * ldb + (lane & 31);
#pragma unroll 2
  for (int k0 = 0; k0 < K; k0 += 16) {
    bf16x8 a = *(const bf16x8*)(ap + k0);
    bf16x8 b;
#pragma unroll
    for (int j = 0; j < 8; ++j) b[j] = (short)bp[(k0 + j) * ldb];
    acc = __builtin_amdgcn_mfma_f32_32x32x16_bf16(a, b, acc, 0, 0, 0);
  }
}
__device__ __forceinline__ f32x16 zero16() {
  f32x16 z;
#pragma unroll
  for (int i = 0; i < 16; ++i) z[i] = 0.f;
  return z;
}
__device__ __forceinline__ int q_next(const Params& p, int qi, char* smem) {
  int* sj = (int*)(smem + SJ_OFF);
  __syncthreads();
  if (threadIdx.x == 0) {
    guint* ctr = (guint*)(p.ws() + WS_CTR) + qi;
    *sj = (int)__hip_atomic_fetch_add(ctr, 1u, __ATOMIC_RELAXED, __HIP_MEMORY_SCOPE_AGENT);
  }
  __syncthreads();
  return *sj;
}
__device__ __forceinline__ void stage_rows128(u16* dst, const gu16* src, size_t ld, int nvalid, int tid) {
  for (int idx = tid; idx < 64 * 16; idx += 256) {
    const int i = idx >> 4, ch = idx & 15;
    uint4 v = make_uint4(0, 0, 0, 0);
    if (i < nvalid) v = gld16(src + (size_t)i * ld + ch * 8);
    *(uint4*)(dst + i * 136 + ch * 8) = v;
  }
}
__device__ __forceinline__ void stage_64x64(u16* dst, const gu16* src, int tid) {
  for (int idx = tid; idx < 64 * 8; idx += 256) {
    const int i = idx >> 3, ch = idx & 7;
    *(uint4*)(dst + i * 72 + ch * 8) = gld16(src + i * 64 + ch * 8);
  }
}

__device__ __forceinline__ int map_col(int type, int n, int nsrc) {
  if (type == 0) return n < nsrc ? n : -1;
  if (type == 1) {
    if (n < 1024) return n;
    if (n < 2048) return n + 16;
    if (n < 2064) return n - 1024;
    return -1;
  }
  if (n < 1024) return n + 512;
  if (n < 2560) return n + 520;
  if (n < 3072) return n - 2560;
  if (n < 3584) return n + 8;
  if (n < 3592) return n - 2048;
  if (n < 3600) return n;
  return -1;
}
__device__ __forceinline__ void convert_tile(const gf32* __restrict__ W, int K, int nsrc, gu16* __restrict__ dst, int ndst, int type,
                                             char* smem, int t) {
  float* tl = (float*)smem;
  const int tid = opaque_tid();
  const int nkt = K / 64;
  const int k0 = (t % nkt) * 64, n0 = (t / nkt) * 64;
  __syncthreads();
  const int c = tid & 63;
  const int sc = map_col(type, n0 + c, nsrc);
#pragma unroll 4
  for (int i = 0; i < 16; ++i) {
    const int r = (tid >> 6) + 4 * i;
    tl[r * 65 + c] = sc >= 0 ? W[(size_t)(k0 + r) * nsrc + sc] : 0.f;
  }
  __syncthreads();
  const int n = tid >> 2, kq = (tid & 3) * 16;
  unsigned pk[8];
#pragma unroll
  for (int j = 0; j < 8; ++j) pk[j] = pack2(tl[(kq + 2 * j) * 65 + n], tl[(kq + 2 * j + 1) * 65 + n]);
  gu16* d = dst + (size_t)(n0 + n) * K + k0 + kq;
  gst16(d, make_uint4(pk[0], pk[1], pk[2], pk[3]));
  gst16(d + 8, make_uint4(pk[4], pk[5], pk[6], pk[7]));
}
__device__ __forceinline__ void convert_weight(const gf32* __restrict__ W, int K, int nsrc, gu16* __restrict__ dst, int ndst, int type,
                               char* smem) {
  const int ntl = (K / 64) * (ndst / 64);
  for (int t = blockIdx.x; t < ntl; t += gridDim.x) convert_tile(W, K, nsrc, dst, ndst, type, smem, t);
}
__device__ __forceinline__ void convert_filler(const Params& p, int layer, int fj, char* smem) {
  gchar* W = p.ws() + WS_W;
  if (layer == 0) {
    if (fj < 64) convert_tile(p.in(I_W_S5_GLU), 512, 512, (gu16*)(W + W_GLU), 512, 0, smem, fj);
    else if (fj < 320) convert_tile(p.in(I_W_OUT_AB), 1024, 1024, (gu16*)(W + W_OUTAB), 1024, 0, smem, fj - 64);
    else if (fj < 1344) convert_tile(p.in(I_W_UP), 1024, 4096, (gu16*)(W + W_UP0), 4096, 0, smem, fj - 320);
    else convert_tile(p.in(I_W_DOWN), 4096, 1024, (gu16*)(W + W_DOWN0), 1024, 0, smem, fj - 1344);
  } else {
    if (fj < 256) convert_tile(p.in(I_W_OUT_CD), 1024, 1024, (gu16*)(W + W_OUTCD), 1024, 0, smem, fj);
    else if (fj < 1280) convert_tile(p.in(I_W_UP) + (size_t)1024 * 4096, 1024, 4096, (gu16*)(W + W_UP1), 4096, 0, smem, fj - 256);
    else convert_tile(p.in(I_W_DOWN) + (size_t)4096 * 1024, 4096, 1024, (gu16*)(W + W_DOWN1), 1024, 0, smem, fj - 1280);
  }
}

__device__ __forceinline__ void norm_phase(const Params& p, int mode, const gf32* __restrict__ g, int slabmode) {
  const int tid = opaque_tid(), lane = tid & 63;
  const int wg = blockIdx.x * 4 + (tid >> 6), nw = gridDim.x * 4;
  gu16* HC = (gu16*)(p.ws() + WS_HC);
  const gf32* slab = (const gf32*)(p.ws() + WS_SLAB);
  float4 gg[4];
#pragma unroll
  for (int m = 0; m < 4; ++m) gg[m] = gldf4(g + m * 256 + lane * 4);
  for (int row0 = wg; row0 < T_ALL; row0 += 2 * nw) {
    float4 v[2][4];
    float ss[2] = {0.f, 0.f};
    bool ok[2], fold[2];
#pragma unroll
    for (int u = 0; u < 2; ++u) {
      const int row = row0 + u * nw;
      ok[u] = row < T_ALL;
      fold[u] = ok[u] && slabmode != 0 && row >= T_P;
      if (ok[u]) {
        const gf32* src;
        if (mode == 0) src = row < T_P ? p.in(I_XP) + (size_t)row * 1024 : p.in(I_XS) + (size_t)(row - T_P) * 1024;
        else src = p.out() + (size_t)row * 1024;
        if (fold[u] && slabmode == 2) src = p.in(I_XS) + (size_t)(row - T_P) * 1024;
#pragma unroll
        for (int m = 0; m < 4; ++m) v[u][m] = gldf4(src + m * 256 + lane * 4);
      } else {
#pragma unroll
        for (int m = 0; m < 4; ++m) v[u][m] = make_float4(0.f, 0.f, 0.f, 0.f);
      }
    }
#pragma unroll
    for (int u = 0; u < 2; ++u) {
      const int row = row0 + u * nw;
      if (fold[u]) {
#pragma unroll
        for (int m = 0; m < 4; ++m) {
#pragma unroll
          for (int s = 0; s < 4; ++s) {
            const float4 t = gldf4(slab + ((size_t)s * 128 + (row - T_P)) * 1024 + m * 256 + lane * 4);
            v[u][m].x += t.x; v[u][m].y += t.y; v[u][m].z += t.z; v[u][m].w += t.w;
          }
          if (mode != 2) gstf4(p.out() + (size_t)row * 1024 + m * 256 + lane * 4, v[u][m]);
        }
      }
#pragma unroll
      for (int m = 0; m < 4; ++m) ss[u] += v[u][m].x * v[u][m].x + v[u][m].y * v[u][m].y + v[u][m].z * v[u][m].z + v[u][m].w * v[u][m].w;
      ss[u] = wave_sum(ss[u]);
    }
#pragma unroll
    for (int u = 0; u < 2; ++u) {
      const int row = row0 + u * nw;
      if (!ok[u]) continue;
      const float rstd = rsqrtf(ss[u] * (1.f / 1024.f) + 1e-6f);
#pragma unroll
      for (int m = 0; m < 4; ++m) {
        const float y0 = v[u][m].x * rstd * gg[m].x, y1 = v[u][m].y * rstd * gg[m].y, y2 = v[u][m].z * rstd * gg[m].z, y3 = v[u][m].w * rstd * gg[m].w;
        if (mode == 2) gstf4(p.out() + (size_t)row * 1024 + m * 256 + lane * 4, make_float4(y0, y1, y2, y3));
        else gst8(HC + (size_t)row * 1024 + m * 256 + lane * 4, make_uint2(pack2(y0, y1), pack2(y2, y3)));
      }
    }
  }
}

__device__ __forceinline__ float4 ld_bf4(const gu16* p) {
  const uint2 r = gld8(p);
  return make_float4(__uint_as_float(r.x << 16), __uint_as_float(r.x & 0xffff0000u), __uint_as_float(r.y << 16),
                     __uint_as_float(r.y & 0xffff0000u));
}
__device__ __forceinline__ void st_bf4(gu16* p, float a, float b, float c, float d) {
  gst8(p, make_uint2(pack2_hw(a, b), pack2_hw(c, d)));
}

enum { EPI_INAB = 0, EPI_GLU, EPI_RES0, EPI_RES, EPI_UP, EPI_INCD, EPI_SLAB };
struct Epi {
  gu16* ob;
  gu16* ob2;
  gf32* of;
  const gf32* x0;
  const gf32* x1;
  const gu16* yb;
  const gf32* bias;
};

template <int EPI>
__device__ __forceinline__ void epi_store4(const Epi& e, int row, int col, float v0, float v1, float v2, float v3) {
  if (EPI == EPI_INAB) {
    st_bf4(e.ob + (size_t)row * N_AB + col, v0, v1, v2, v3);
  } else if (EPI == EPI_GLU) {
    const float4 y = ld_bf4(e.yb + (size_t)row * 512 + col);
    const float4 b = gldf4(e.bias + col);
    st_bf4(e.ob + (size_t)row * 1024 + 512 + col, y.x * sigmoidf_(v0 + b.x), y.y * sigmoidf_(v1 + b.y),
           y.z * sigmoidf_(v2 + b.z), y.w * sigmoidf_(v3 + b.w));
  } else if (EPI == EPI_RES0) {
    const gf32* xr = row < T_P ? e.x0 + (size_t)row * 1024 : e.x1 + (size_t)(row - T_P) * 1024;
    const float4 x = gldf4(xr + col);
    gstf4(e.of + (size_t)row * 1024 + col, make_float4(x.x + v0, x.y + v1, x.z + v2, x.w + v3));
  } else if (EPI == EPI_RES) {
    gf32* o = e.of + (size_t)row * 1024 + col;
    const float4 x = gldf4(o);
    gstf4(o, make_float4(x.x + v0, x.y + v1, x.z + v2, x.w + v3));
  } else if (EPI == EPI_UP) {
    const float r0 = fmaxf(v0, 0.f), r1 = fmaxf(v1, 0.f), r2 = fmaxf(v2, 0.f), r3 = fmaxf(v3, 0.f);
    st_bf4(e.ob + (size_t)row * 4096 + col, r0 * r0, r1 * r1, r2 * r2, r3 * r3);
  } else if (EPI == EPI_SLAB) {
    gstf4(e.of + (size_t)row * 1024 + col, make_float4(v0, v1, v2, v3));
  } else {
    if (col < 2560) st_bf4(e.ob + (size_t)row * 2560 + col, v0, v1, v2, v3);
    else if (col < 3600) st_bf4(e.ob2 + (size_t)row * 1040 + (col - 2560), v0, v1, v2, v3);
  }
}

template <int EPI>
__device__ __forceinline__ void gemm_tile_at(const gu16* __restrict__ A, int lda, const gu16* __restrict__ Bt, int ldb, int nk,
                                             int m0, int n0, const Epi& e, char* smem,
                                             bool prefetched = false, bool has_next = false, int nm0 = 0, int nn0 = 0) {
  u16* As = (u16*)smem;
  u16* Bs = As + 2 * 128 * 72;
  const int tid = opaque_tid(), lane = tid & 63, wm = (tid >> 7) & 1, wn = (tid >> 6) & 1;
  const int wave = __builtin_amdgcn_readfirstlane(tid >> 6);
  const bool isB = wave >= 2;
  const int li0 = (wave & 1) * 9;
  const gu16* gsrc = isB ? Bt + (size_t)n0 * ldb : A + (size_t)m0 * lda;
  const int ld = isB ? ldb : lda;
  int goff[9];
#pragma unroll
  for (int i = 0; i < 9; ++i) {
    const int c = (li0 + i) * 64 + lane, row = c / 9, ch = c - row * 9;
    goff[i] = row * ld + (ch < 8 ? ch : 7) * 8;
  }
  char* lbase = (char*)(isB ? Bs : As) + li0 * 1024;
  f32x16 acc00 = zero16(), acc01 = zero16(), acc10 = zero16(), acc11 = zero16();
#define G_DMA(buf, koff)                                                                                         \
  _Pragma("unroll") for (int i = 0; i < 9; ++i)                                                                  \
    __builtin_amdgcn_global_load_lds((const unsigned*)(gsrc + goff[i] + (koff)), (unsigned*)(lbase + (buf) * 18432 + i * 1024), 16, 0, 0);
#define G_FRAG(ks, A0, A1, B0, B1)                         \
    A0 = *(const bf16x8*)(as + (ks) * 16);                 \
    A1 = *(const bf16x8*)(as + 32 * 72 + (ks) * 16);       \
    B0 = *(const bf16x8*)(bs + (ks) * 16);                 \
    B1 = *(const bf16x8*)(bs + 32 * 72 + (ks) * 16);
#define G_MMA(A0, A1, B0, B1)                                                        \
    acc00 = __builtin_amdgcn_mfma_f32_32x32x16_bf16(B0, A0, acc00, 0, 0, 0);         \
    acc01 = __builtin_amdgcn_mfma_f32_32x32x16_bf16(B1, A0, acc01, 0, 0, 0);         \
    acc10 = __builtin_amdgcn_mfma_f32_32x32x16_bf16(B0, A1, acc10, 0, 0, 0);         \
    acc11 = __builtin_amdgcn_mfma_f32_32x32x16_bf16(B1, A1, acc11, 0, 0, 0);
#define G_COMPUTE(buf)                                                                                   \
  {                                                                                                      \
    const u16* as = As + (buf) * 128 * 72 + (wm * 64 + (lane & 31)) * 72 + 8 * (lane >> 5);              \
    const u16* bs = Bs + (buf) * 128 * 72 + (wn * 64 + (lane & 31)) * 72 + 8 * (lane >> 5);              \
    bf16x8 pa0, pa1, pb0, pb1, qa0, qa1, qb0, qb1;                                                       \
    G_FRAG(0, pa0, pa1, pb0, pb1)                                                                        \
    G_FRAG(1, qa0, qa1, qb0, qb1)                                                                        \
    G_MMA(pa0, pa1, pb0, pb1)                                                                            \
    G_FRAG(2, pa0, pa1, pb0, pb1)                                                                        \
    G_MMA(qa0, qa1, qb0, qb1)                                                                            \
    G_FRAG(3, qa0, qa1, qb0, qb1)                                                                        \
    G_MMA(pa0, pa1, pb0, pb1)                                                                            \
    G_MMA(qa0, qa1, qb0, qb1)                                                                            \
  }
  if (!prefetched) {
    __syncthreads();
    G_DMA(0, 0)
  }
  __syncthreads();
  for (int kt = 0; kt < nk; ++kt) {
    const int cur = kt & 1;
    if (kt + 1 < nk) { G_DMA(cur ^ 1, (kt + 1) * 64) }
    if (cur == 0) G_COMPUTE(0) else G_COMPUTE(1)
    __syncthreads();
  }
  if (has_next) {
    const gu16* gnext = isB ? Bt + (size_t)nn0 * ldb : A + (size_t)nm0 * lda;
#pragma unroll
    for (int i = 0; i < 9; ++i)
      __builtin_amdgcn_global_load_lds((const unsigned*)(gnext + goff[i]), (unsigned*)(lbase + i * 1024), 16, 0, 0);
  }
#undef G_DMA
#undef G_COMPUTE
#undef G_FRAG
#undef G_MMA
  const int rowb = m0 + wm * 64 + (lane & 31), colb = n0 + wn * 64 + 4 * (lane >> 5);
  if (EPI == EPI_RES || EPI == EPI_RES0) {
    const gf32* s0p; const gf32* s1p;
    if (EPI == EPI_RES0) {
      s0p = rowb < T_P ? e.x0 + (size_t)rowb * 1024 : e.x1 + (size_t)(rowb - T_P) * 1024;
      s1p = (rowb + 32) < T_P ? e.x0 + (size_t)(rowb + 32) * 1024 : e.x1 + (size_t)(rowb + 32 - T_P) * 1024;
    } else {
      s0p = e.of + (size_t)rowb * 1024;
      s1p = e.of + (size_t)(rowb + 32) * 1024;
    }
    float4 xr[16];
#pragma unroll
    for (int gq = 0; gq < 4; ++gq) {
      const int c = colb + 8 * gq;
      xr[4 * gq + 0] = gldf4(s0p + c); xr[4 * gq + 1] = gldf4(s0p + c + 32);
      xr[4 * gq + 2] = gldf4(s1p + c); xr[4 * gq + 3] = gldf4(s1p + c + 32);
    }
    gf32* d0p = e.of + (size_t)rowb * 1024;
    gf32* d1p = e.of + (size_t)(rowb + 32) * 1024;
#pragma unroll
    for (int gq = 0; gq < 4; ++gq) {
      const int c = colb + 8 * gq;
      float4 x;
      x = xr[4 * gq + 0]; gstf4(d0p + c, make_float4(x.x + acc00[4 * gq], x.y + acc00[4 * gq + 1], x.z + acc00[4 * gq + 2], x.w + acc00[4 * gq + 3]));
      x = xr[4 * gq + 1]; gstf4(d0p + c + 32, make_float4(x.x + acc01[4 * gq], x.y + acc01[4 * gq + 1], x.z + acc01[4 * gq + 2], x.w + acc01[4 * gq + 3]));
      x = xr[4 * gq + 2]; gstf4(d1p + c, make_float4(x.x + acc10[4 * gq], x.y + acc10[4 * gq + 1], x.z + acc10[4 * gq + 2], x.w + acc10[4 * gq + 3]));
      x = xr[4 * gq + 3]; gstf4(d1p + c + 32, make_float4(x.x + acc11[4 * gq], x.y + acc11[4 * gq + 1], x.z + acc11[4 * gq + 2], x.w + acc11[4 * gq + 3]));
    }
    return;
  }
  if (EPI == EPI_GLU) {
#pragma unroll
    for (int hq = 0; hq < 2; ++hq) {
      float4 yv[8], bv[4];
#pragma unroll
      for (int g2 = 0; g2 < 2; ++g2) {
        const int c = colb + 8 * (2 * hq + g2);
        yv[4 * g2 + 0] = ld_bf4(e.yb + (size_t)rowb * 512 + c); yv[4 * g2 + 1] = ld_bf4(e.yb + (size_t)rowb * 512 + c + 32);
        yv[4 * g2 + 2] = ld_bf4(e.yb + (size_t)(rowb + 32) * 512 + c); yv[4 * g2 + 3] = ld_bf4(e.yb + (size_t)(rowb + 32) * 512 + c + 32);
        bv[2 * g2] = gldf4(e.bias + c); bv[2 * g2 + 1] = gldf4(e.bias + c + 32);
      }
#pragma unroll
      for (int g2 = 0; g2 < 2; ++g2) {
        const int gq = 2 * hq + g2, c = colb + 8 * gq;
        float4 y, b;
        y = yv[4 * g2 + 0]; b = bv[2 * g2];
        st_bf4(e.ob + (size_t)rowb * 1024 + 512 + c, y.x * sigmoidf_(acc00[4 * gq] + b.x), y.y * sigmoidf_(acc00[4 * gq + 1] + b.y), y.z * sigmoidf_(acc00[4 * gq + 2] + b.z), y.w * sigmoidf_(acc00[4 * gq + 3] + b.w));
        y = yv[4 * g2 + 1]; b = bv[2 * g2 + 1];
        st_bf4(e.ob + (size_t)rowb * 1024 + 512 + c + 32, y.x * sigmoidf_(acc01[4 * gq] + b.x), y.y * sigmoidf_(acc01[4 * gq + 1] + b.y), y.z * sigmoidf_(acc01[4 * gq + 2] + b.z), y.w * sigmoidf_(acc01[4 * gq + 3] + b.w));
        y = yv[4 * g2 + 2]; b = bv[2 * g2];
        st_bf4(e.ob + (size_t)(rowb + 32) * 1024 + 512 + c, y.x * sigmoidf_(acc10[4 * gq] + b.x), y.y * sigmoidf_(acc10[4 * gq + 1] + b.y), y.z * sigmoidf_(acc10[4 * gq + 2] + b.z), y.w * sigmoidf_(acc10[4 * gq + 3] + b.w));
        y = yv[4 * g2 + 3]; b = bv[2 * g2 + 1];
        st_bf4(e.ob + (size_t)(rowb + 32) * 1024 + 512 + c + 32, y.x * sigmoidf_(acc11[4 * gq] + b.x), y.y * sigmoidf_(acc11[4 * gq + 1] + b.y), y.z * sigmoidf_(acc11[4 * gq + 2] + b.z), y.w * sigmoidf_(acc11[4 * gq + 3] + b.w));
      }
    }
    return;
  }
#pragma unroll
  for (int gq = 0; gq < 4; ++gq) {
    const int c = colb + 8 * gq;
    epi_store4<EPI>(e, rowb, c, acc00[4 * gq], acc00[4 * gq + 1], acc00[4 * gq + 2], acc00[4 * gq + 3]);
    epi_store4<EPI>(e, rowb, c + 32, acc01[4 * gq], acc01[4 * gq + 1], acc01[4 * gq + 2], acc01[4 * gq + 3]);
    epi_store4<EPI>(e, rowb + 32, c, acc10[4 * gq], acc10[4 * gq + 1], acc10[4 * gq + 2], acc10[4 * gq + 3]);
    epi_store4<EPI>(e, rowb + 32, c + 32, acc11[4 * gq], acc11[4 * gq + 1], acc11[4 * gq + 2], acc11[4 * gq + 3]);
    __builtin_amdgcn_sched_barrier(0);
  }
}

template <int EPI>
__device__ __forceinline__ void gemm_tile(const gu16* __restrict__ A, int lda, const gu16* __restrict__ Bt, int K, int ntn, const Epi& e,
                                          char* smem, int tile) {
  gemm_tile_at<EPI>(A, lda, Bt, K, K / 64, (tile / ntn) * 128, (tile % ntn) * 128, e, smem);
}
template <int EPI>
__device__ __forceinline__ void gemm_phase_n(const gu16* __restrict__ A, int lda, const gu16* __restrict__ Bt, int K, int ntn, int ntiles,
                                             const Epi& e, char* smem) {
  bool pf = false;
  for (int tile = blockIdx.x; tile < ntiles; tile += gridDim.x) {
    const int nt = tile + gridDim.x;
    const bool hn = nt < ntiles;
    gemm_tile_at<EPI>(A, lda, Bt, K, K / 64, (tile / ntn) * 128, (tile % ntn) * 128, e, smem, pf, hn, (nt / ntn) * 128, (nt % ntn) * 128);
    pf = hn;
  }
}
template <int EPI>
__device__ __forceinline__ void gemm_phase(const gu16* __restrict__ A, int lda, const gu16* __restrict__ Bt, int K, int ntn, const Epi& e,
                           char* smem) {
  gemm_phase_n<EPI>(A, lda, Bt, K, ntn, 129 * ntn, e, smem);
}
template <int EPI>
__device__ __forceinline__ void gemm_phase_xcd(const gu16* __restrict__ A, int lda, const gu16* __restrict__ Bt, int K, int ntn, const Epi& e,
                                               char* smem) {
  const int ntiles = 129 * ntn, C = (ntiles + 7) >> 3;
  bool pf = false;
  for (int j = blockIdx.x; j < 8 * C; j += gridDim.x) {
    const int tile = (j & 7) * C + (j >> 3);
    const int jn = j + gridDim.x, tn = (jn & 7) * C + (jn >> 3);
    const bool hn = jn < 8 * C && tn < ntiles;
    if (tile < ntiles) {
      gemm_tile_at<EPI>(A, lda, Bt, K, K / 64, (tile / ntn) * 128, (tile % ntn) * 128, e, smem, pf, hn, (tn / ntn) * 128, (tn % ntn) * 128);
      pf = hn;
    }
  }
}
template <int EPI>
__device__ __forceinline__ void gemm_res_phase(const gu16* __restrict__ A, int lda, const gu16* __restrict__ Bt, int K, const Epi& e,
                                               gf32* slab, char* smem) {
  bool pf = false;
  for (int job = blockIdx.x; job < 1024 + 32; job += gridDim.x) {
    if (job < 1024) {
      const int r = job >> 9, jj = job & 511, x = jj & 7, q = jj >> 3;
      const int jn = job + gridDim.x;
      const bool hn = jn < 1024;
      const int rn = jn >> 9, jjn = jn & 511, xn = jjn & 7, qn = jjn >> 3;
      gemm_tile_at<EPI>(A, lda, Bt, K, K / 64, (64 * r + 8 * x + (q >> 3)) * 128, (q & 7) * 128, e, smem, pf, hn,
                        (64 * rn + 8 * xn + (qn >> 3)) * 128, (qn & 7) * 128);
      pf = hn;
    } else {
      const int j = job - 1024, ks = j >> 3, kq = K / 4;
      Epi es = e;
      es.of = slab + (size_t)ks * 128 * 1024 - (size_t)T_P * 1024;
      gemm_tile_at<EPI_SLAB>(A + (size_t)ks * kq, lda, Bt + (size_t)ks * kq, K, kq / 64, T_P, (j & 7) * 128, es, smem);
    }
  }
}

constexpr size_t GA_OFF = 0;
constexpr size_t GK_OFF = GA_OFF + (size_t)1536 * 64 * 128 * 2;
constexpr size_t GE_OFF = GK_OFF + (size_t)1536 * 64 * 64 * 2;
static_assert(GE_OFF + (size_t)1536 * 64 * 4 <= (size_t)T_ALL * 1536 * 2, "GLA prepass buffers must fit the QKV region");

__device__ __forceinline__ void gla_prep_unit(const Params& p, int u, char* smem) {
  const int tid = opaque_tid(), lane = tid & 63, wave = tid >> 6;
  int h, nvalid;
  size_t row0;
  if (u < 1024) { const int chain = u >> 5; h = chain & 3; row0 = (size_t)(chain >> 2) * 2048 + (size_t)(u & 31) * 64; nvalid = 64; }
  else { const int j2 = u - 1024; h = j2 & 3; row0 = (size_t)T_P + (j2 >> 2); nvalid = 1; }
  const gu16* Pab = (const gu16*)(p.ws() + WS_R1 + R1_PAB);
  gu16* GA = (gu16*)(p.ws() + WS_QKV + GA_OFF) + (size_t)u * 8192;
  gu16* GK = (gu16*)(p.ws() + WS_QKV + GK_OFF) + (size_t)u * 4096;
  gf32* GE = (gf32*)(p.ws() + WS_QKV + GE_OFF) + (size_t)u * 64;
  u16* AQ = (u16*)smem;
  u16* Kt = AQ + 64 * 136;
  float* cum = (float*)(Kt + 64 * 72);
  float* glr = cum + 64 * 64;
  float* Wg = glr + 64 * 16;
  float* bg = Wg + 16 * 64;
  const int kk = tid & 63;
  __syncthreads();
  for (int idx = tid; idx < 16 * 64; idx += 256) Wg[idx] = p.in(I_W_GLA_GATE)[(idx >> 6) * 256 + h * 64 + (idx & 63)];
  if (tid < 64) bg[tid] = p.in(I_B_GLA_GATE)[h * 64 + tid];
  for (int idx = tid; idx < 64 * 16; idx += 256) {
    const int i = idx >> 4, r = idx & 15;
    glr[idx] = (i < nvalid) ? bf2f(Pab[(row0 + i) * N_AB + 2048 + r]) : 0.f;
  }
  float qv[16], kv[16];
#pragma unroll
  for (int m = 0; m < 16; ++m) {
    const int i = (tid >> 6) + 4 * m;
    const bool ok = i < nvalid;
    qv[m] = ok ? bf2f(Pab[(row0 + i) * N_AB + h * 64 + kk]) : 0.f;
    kv[m] = ok ? bf2f(Pab[(row0 + i) * N_AB + 256 + h * 64 + kk]) : 0.f;
  }
  __syncthreads();
#pragma unroll 2
  for (int m = 0; m < 16; ++m) {
    const int i = (tid >> 6) + 4 * m;
    float x = bg[kk];
#pragma unroll
    for (int r = 0; r < 16; ++r) x += glr[i * 16 + r] * Wg[r * 64 + kk];
    cum[i * 64 + kk] = (i < nvalid) ? (-softplusf_(-x)) * (1.f / 16.f) : 0.f;
  }
  __syncthreads();
  if (tid < 64) {
    float a = 0.f;
#pragma unroll 1
    for (int i0 = 0; i0 < 64; i0 += 16) {
      float t[16];
#pragma unroll
      for (int u = 0; u < 16; ++u) t[u] = cum[(i0 + u) * 64 + tid];
#pragma unroll
      for (int u = 0; u < 16; ++u) { a += t[u]; cum[(i0 + u) * 64 + tid] = a; }
    }
    GE[tid] = __expf(a);
  }
  __syncthreads();
#pragma unroll
  for (int m = 0; m < 16; ++m) {
    const int i = (tid >> 6) + 4 * m;
    const float cm = cum[i * 64 + kk];
    AQ[i * 136 + 64 + kk] = f2bf(qv[m] * 0.125f * __expf(cm));
    Kt[i * 72 + kk] = f2bf(kv[m] * __expf(-cm));
  }
  __syncthreads();
  {
    const int mi = wave >> 1, ni = wave & 1;
    f32x16 acc = zero16();
    mma_tile(acc, AQ + mi * 32 * 136 + 64, 136, Kt + ni * 32 * 72, 72, 64, lane);
    const int jj = ni * 32 + (lane & 31);
#pragma unroll
    for (int r = 0; r < 16; ++r) {
      const int i = mi * 32 + TROW(r, lane);
      AQ[i * 136 + jj] = f2bf(jj <= i ? acc[r] : 0.f);
    }
  }
  __syncthreads();
  for (int idx = tid; idx < 64 * 16; idx += 256) {
    const int i = idx >> 4, ch = idx & 15;
    gst16(GA + i * 128 + ch * 8, *(const uint4*)(AQ + i * 136 + ch * 8));
  }
  for (int idx = tid; idx < 64 * 8; idx += 256) {
    const int i = idx >> 3, ch = idx & 7;
    gst16(GK + i * 64 + ch * 8, *(const uint4*)(Kt + i * 72 + ch * 8));
  }
}

__device__ __forceinline__ void gla_seq_unit(const Params& p, int job, char* smem) {
  const int tid = opaque_tid(), lane = tid & 63, wave = tid >> 6;
  int tok0, nchunks, nvalid, h, vs, ubase;
  const gf32* s0;
  gf32* sout;
  if (job < 128) {
    const int chain = job >> 2;
    vs = job & 3; h = chain & 3; ubase = chain * 32;
    tok0 = (chain >> 2) * 2048; nchunks = 32; nvalid = 64; s0 = nullptr;
    sout = p.out() + O_PGLA + (size_t)chain * 8192;
  } else {
    const int j2 = job - 128, chain = j2 >> 2;
    vs = j2 & 3; h = chain & 3; ubase = 1024 + chain;
    tok0 = T_P + (chain >> 2); nchunks = 1; nvalid = 1;
    s0 = p.in(I_ST_GLA) + (size_t)chain * 8192;
    sout = p.out() + O_SGLA + (size_t)chain * 8192;
  }
  const gu16* Pab = (const gu16*)(p.ws() + WS_R1 + R1_PAB);
  gf32* OG = (gf32*)(p.ws() + WS_R1 + R1_OG);
  const gu16* GA = (const gu16*)(p.ws() + WS_QKV + GA_OFF);
  const gu16* GK = (const gu16*)(p.ws() + WS_QKV + GK_OFF);
  const gf32* GE = (const gf32*)(p.ws() + WS_QKV + GE_OFF);
  u16* AQ = (u16*)smem;
  u16* Kt = AQ + 64 * 136;
  u16* VS = Kt + 64 * 72;
  float* el = (float*)(VS + 32 * 136);
  __syncthreads();
  f32x16 accS = zero16();
  if (wave < 2) {
    const int k = wave * 32 + (lane & 31);
#pragma unroll
    for (int r = 0; r < 16; ++r) {
      const int v = TROW(r, lane);
      if (s0) accS[r] = s0[(size_t)k * 128 + vs * 32 + v];
      VS[v * 136 + 64 + k] = f2bf(accS[r]);
    }
  }
  const int vj = tid >> 2, vq = (tid & 3) * 8;
  uint4 pa0, pa1, pa2, pa3, pk0, pk1, pv;
  float pe = 0.f;
#define GLA_LOAD(c_)                                                                                     \
  {                                                                                                      \
    const size_t u_ = (size_t)ubase + (c_);                                                              \
    const size_t r0_ = (size_t)tok0 + (size_t)(c_) * 64;                                                 \
    const gu16* ga_ = GA + u_ * 8192;                                                                    \
    const gu16* gk_ = GK + u_ * 4096;                                                                    \
    pa0 = gld16(ga_ + (size_t)(tid + 0) * 8);   pa1 = gld16(ga_ + (size_t)(tid + 256) * 8);              \
    pa2 = gld16(ga_ + (size_t)(tid + 512) * 8); pa3 = gld16(ga_ + (size_t)(tid + 768) * 8);              \
    pk0 = gld16(gk_ + (size_t)(tid + 0) * 8);   pk1 = gld16(gk_ + (size_t)(tid + 256) * 8);              \
    pv = make_uint4(0, 0, 0, 0);                                                                         \
    if (vj < nvalid) pv = gld16(Pab + (r0_ + vj) * N_AB + 512 + h * 128 + vs * 32 + vq);                 \
    if (tid < 64) pe = GE[u_ * 64 + tid];                                                                \
  }
  GLA_LOAD(0)
  for (int c = 0; c < nchunks; ++c) {
    const size_t row0 = (size_t)tok0 + (size_t)c * 64;
    {
      int idx = tid;       *(uint4*)(AQ + (idx >> 4) * 136 + (idx & 15) * 8) = pa0;
      idx = tid + 256;     *(uint4*)(AQ + (idx >> 4) * 136 + (idx & 15) * 8) = pa1;
      idx = tid + 512;     *(uint4*)(AQ + (idx >> 4) * 136 + (idx & 15) * 8) = pa2;
      idx = tid + 768;     *(uint4*)(AQ + (idx >> 4) * 136 + (idx & 15) * 8) = pa3;
      idx = tid;           *(uint4*)(Kt + (idx >> 3) * 72 + (idx & 7) * 8) = pk0;
      idx = tid + 256;     *(uint4*)(Kt + (idx >> 3) * 72 + (idx & 7) * 8) = pk1;
      VS[(vq + 0) * 136 + vj] = (u16)(pv.x & 0xffffu); VS[(vq + 1) * 136 + vj] = (u16)(pv.x >> 16);
      VS[(vq + 2) * 136 + vj] = (u16)(pv.y & 0xffffu); VS[(vq + 3) * 136 + vj] = (u16)(pv.y >> 16);
      VS[(vq + 4) * 136 + vj] = (u16)(pv.z & 0xffffu); VS[(vq + 5) * 136 + vj] = (u16)(pv.z >> 16);
      VS[(vq + 6) * 136 + vj] = (u16)(pv.w & 0xffffu); VS[(vq + 7) * 136 + vj] = (u16)(pv.w >> 16);
      if (tid < 64) el[tid] = pe;
    }
    __syncthreads();
    if (c + 1 < nchunks) GLA_LOAD(c + 1)
    if (wave >= 2) {
      const int mi = wave - 2;
      f32x16 acc = zero16();
      mma_tile(acc, AQ + mi * 32 * 136, 136, VS, 136, 128, lane);
      const int v = lane & 31;
#pragma unroll
      for (int r = 0; r < 16; ++r) {
        const int i = mi * 32 + TROW(r, lane);
        if (i < nvalid) OG[(row0 + i) * 512 + h * 128 + vs * 32 + v] = acc[r];
      }
    } else {
      mma_tile_bg(accS, VS, 136, Kt + wave * 32, 72, 64, lane);
      const float e = el[wave * 32 + (lane & 31)];
#pragma unroll
      for (int r = 0; r < 16; ++r) accS[r] *= e;
    }
    __syncthreads();
    if (wave < 2) {
      const int k = wave * 32 + (lane & 31);
#pragma unroll
      for (int r = 0; r < 16; ++r) VS[TROW(r, lane) * 136 + 64 + k] = f2bf(accS[r]);
    }
  }
#undef GLA_LOAD
  if (wave < 2) {
    const int k = wave * 32 + (lane & 31);
#pragma unroll
    for (int r = 0; r < 16; ++r) sout[(size_t)k * 128 + vs * 32 + TROW(r, lane)] = accS[r];
  }
}

__device__ __forceinline__ void s5_unit(const Params& p, int job, char* smem) {
  const int tid = opaque_tid(), lane = tid & 63, wave = tid >> 6;
  u16* U = (u16*)smem;
  u16* BB = U + 64 * 24;
  u16* CC = BB + 128 * 24;
  u16* Hb = CC + 32 * 136;
  float* BU = (float*)(Hb + 64 * 136);
  float* ar = BU + 64 * 128;
  float* ai = ar + 64;
  const bool seq = job < 256;
  int g, b = 0, half = 0, tok0, nchunks;
  if (seq) { b = job >> 5; g = job & 31; tok0 = b * 2048; nchunks = 32; }
  else { const int j2 = job - 256; g = j2 >> 1; half = j2 & 1; tok0 = T_P + half * 64; nchunks = 1; }
  const gu16* Pab = (const gu16*)(p.ws() + WS_R1 + R1_PAB);
  gu16* Ybf = (gu16*)(p.ws() + WS_R1 + R1_YBF);
  float a_re = 0.f, a_im = 0.f, h_re = 0.f, h_im = 0.f;
  __syncthreads();
  if (tid < 64) {
    const int pp = tid;
    const float lr = p.in(I_S5_LAM_RE)[g * 64 + pp], li = p.in(I_S5_LAM_IM)[g * 64 + pp];
    const float dt = expf(p.in(I_S5_LOG_DT)[g]);
    const float mag = expf(lr * dt);
    float rev = li * dt * 0.15915494309189535f;
    rev -= floorf(rev);
    a_re = mag * __builtin_amdgcn_cosf(rev);
    a_im = mag * __builtin_amdgcn_sinf(rev);
    ar[pp] = a_re; ai[pp] = a_im;
    const float den = lr * lr + li * li;
    const float n_re = a_re - 1.f, n_im = a_im;
    const float k_re = (n_re * lr + n_im * li) / den, k_im = (n_im * lr - n_re * li) / den;
    const gf32* bre = p.in(I_S5_B_RE) + (size_t)(g * 64 + pp) * 16;
    const gf32* bim = p.in(I_S5_B_IM) + (size_t)(g * 64 + pp) * 16;
#pragma unroll
    for (int hh = 0; hh < 16; ++hh) {
      const float br = bre[hh], bi = bim[hh];
      BB[(2 * pp) * 24 + hh] = f2bf(k_re * br - k_im * bi);
      BB[(2 * pp + 1) * 24 + hh] = f2bf(k_re * bi + k_im * br);
    }
  }
  for (int idx = tid; idx < 32 * 128; idx += 256) {
    const int hh = idx >> 7, n = idx & 127, pp = n >> 1;
    float v = 0.f;
    if (hh < 16) v = (n & 1) ? -p.in(I_S5_C_IM)[(size_t)(g * 16 + hh) * 64 + pp] : p.in(I_S5_C_RE)[(size_t)(g * 16 + hh) * 64 + pp];
    CC[hh * 136 + n] = f2bf(v);
  }
  const float dd = p.in(I_S5_D)[g * 16 + (lane & 15)];
  uint4 pu = make_uint4(0, 0, 0, 0);
  if (tid < 128) pu = gld16(Pab + ((size_t)tok0 + (tid >> 1)) * N_AB + 1536 + g * 16 + (tid & 1) * 8);
  for (int c = 0; c < nchunks; ++c) {
    const size_t row0 = (size_t)tok0 + (size_t)c * 64;
    if (tid < 128) *(uint4*)(U + (tid >> 1) * 24 + (tid & 1) * 8) = pu;
    __syncthreads();
    if (c + 1 < nchunks && tid < 128) pu = gld16(Pab + (row0 + 64 + (tid >> 1)) * N_AB + 1536 + g * 16 + (tid & 1) * 8);
    for (int t = wave; t < 8; t += 4) {
      const int mi = t >> 2, ni = t & 3;
      f32x16 acc = zero16();
      mma_tile(acc, U + mi * 32 * 24, 24, BB + ni * 32 * 24, 24, 16, lane);
      const int n = ni * 32 + (lane & 31);
#pragma unroll
      for (int r = 0; r < 16; ++r) BU[(mi * 32 + TROW(r, lane)) * 128 + n] = acc[r];
    }
    __syncthreads();
    if (seq) {
      if (tid < 64) {
#pragma unroll 1
        for (int i0 = 0; i0 < 64; i0 += 16) {
          float2 bu[16];
#pragma unroll
          for (int u = 0; u < 16; ++u) bu[u] = *(const float2*)(BU + (i0 + u) * 128 + 2 * tid);
          unsigned hw[16];
#pragma unroll
          for (int u = 0; u < 16; ++u) {
            const float nr = a_re * h_re - a_im * h_im + bu[u].x;
            const float ni_ = a_re * h_im + a_im * h_re + bu[u].y;
            h_re = nr; h_im = ni_;
            hw[u] = pack2_hw(nr, ni_);
          }
#pragma unroll
          for (int u = 0; u < 16; ++u) *(unsigned*)(Hb + (i0 + u) * 136 + 2 * tid) = hw[u];
        }
      }
    } else {
#pragma unroll 4
      for (int m = 0; m < 16; ++m) {
        const int idx = tid + 256 * m, i = idx >> 6, pp = idx & 63;
        const int tok = half * 64 + i;
        const float h0r = p.in(I_ST_S5RE)[((size_t)tok * 32 + g) * 64 + pp];
        const float h0i = p.in(I_ST_S5IM)[((size_t)tok * 32 + g) * 64 + pp];
        const float xr = ar[pp], xi = ai[pp];
        const float nr = xr * h0r - xi * h0i + BU[i * 128 + 2 * pp];
        const float ni_ = xr * h0i + xi * h0r + BU[i * 128 + 2 * pp + 1];
        *(unsigned*)(Hb + i * 136 + 2 * pp) = pack2(nr, ni_);
        p.out()[O_SS5RE + ((size_t)tok * 32 + g) * 64 + pp] = nr;
        p.out()[O_SS5IM + ((size_t)tok * 32 + g) * 64 + pp] = ni_;
      }
    }
    __syncthreads();
    {
      typedef __attribute__((ext_vector_type(4))) float f32x4v;
      f32x4v acc = {0.f, 0.f, 0.f, 0.f};
      const u16* ap = Hb + (wave * 16 + (lane & 15)) * 136 + 8 * (lane >> 4);
      const u16* bp = CC + (lane & 15) * 136 + 8 * (lane >> 4);
#pragma unroll
      for (int ks = 0; ks < 4; ++ks) {
        const bf16x8 a = *(const bf16x8*)(ap + ks * 32);
        const bf16x8 b = *(const bf16x8*)(bp + ks * 32);
        acc = __builtin_amdgcn_mfma_f32_16x16x32_bf16(a, b, acc, 0, 0, 0);
      }
      const int hh = lane & 15;
#pragma unroll
      for (int r = 0; r < 4; ++r) {
        const int i = wave * 16 + (lane >> 4) * 4 + r;
        const float y = acc[r] + dd * bf2f(U[i * 24 + hh]);
        Ybf[(row0 + i) * 512 + g * 16 + hh] = f2bf(geluf_(y));
      }
    }
    __syncthreads();
  }
  if (seq && tid < 64) {
    p.out()[O_PS5RE + ((size_t)b * 32 + g) * 64 + tid] = h_re;
    p.out()[O_PS5IM + ((size_t)b * 32 + g) * 64 + tid] = h_im;
  }
}

__device__ __forceinline__ void ssd_unit(const Params& p, int job, char* smem) {
  const int tid = opaque_tid(), lane = tid & 63, wave = tid >> 6;
  int tok0, nchunks, nvalid, hh, ps;
  const gf32* s0;
  gf32* sout;
  if (job < 128) {
    const int chain = job >> 1;
    ps = job & 1; hh = chain & 7;
    tok0 = (chain >> 3) * 2048; nchunks = 32; nvalid = 64; s0 = nullptr;
    sout = p.out() + O_PSSD + (size_t)chain * 8192;
  } else {
    const int j2 = job - 128, chain = j2 >> 1;
    ps = j2 & 1; hh = chain & 7;
    tok0 = T_P + (chain >> 3); nchunks = 1; nvalid = 1;
    s0 = p.in(I_ST_SSD) + (size_t)chain * 8192;
    sout = p.out() + O_SSSD + (size_t)chain * 8192;
  }
  const int g = hh >> 2;
  const gu16* XBC = (const gu16*)(p.ws() + WS_HC);
  const gf32* SC = (const gf32*)(p.ws() + WS_SC);
  gf32* YS = (gf32*)(p.ws() + WS_R1 + R1_YS);
  u16* Cm = (u16*)smem;
  u16* Bm = Cm + 64 * 136;
  u16* G = Bm + 64 * 136;
  u16* XT = G + 64 * 72;
  u16* XW = XT + 32 * 72;
  u16* SB = XW + 32 * 72;
  float* cum = (float*)(SB + 32 * 136);
  float* dtv = cum + 64;
  const float a = -expf(p.in(I_SSD_A_LOG)[hh]);
  __syncthreads();
  f32x16 accS = zero16();
  {
    const int n = wave * 32 + (lane & 31);
#pragma unroll
    for (int r = 0; r < 16; ++r) {
      const int pr = TROW(r, lane);
      if (s0) accS[r] = s0[(size_t)(ps * 32 + pr) * 128 + n];
      SB[pr * 136 + n] = f2bf(accS[r]);
    }
  }
  const int xj = tid >> 2, xq = (tid & 3) * 8;
  uint4 pb0, pb1, pb2, pb3, pc0, pc1, pc2, pc3, px;
  float pdt = 0.f;
  const uint4 z4 = make_uint4(0, 0, 0, 0);
#define SSD_LD1(dst, m_, off_) { const int idx_ = tid + 256 * (m_); const int i_ = idx_ >> 4; \
    dst = (i_ < nvalid) ? gld16(XBC + (r0_ + i_) * 1024 + (off_) + g * 128 + (idx_ & 15) * 8) : z4; }
#define SSD_LOAD(c_)                                                                     \
  {                                                                                      \
    const size_t r0_ = (size_t)tok0 + (size_t)(c_) * 64;                                 \
    SSD_LD1(pb0, 0, 512) SSD_LD1(pb1, 1, 512) SSD_LD1(pb2, 2, 512) SSD_LD1(pb3, 3, 512)  \
    SSD_LD1(pc0, 0, 768) SSD_LD1(pc1, 1, 768) SSD_LD1(pc2, 2, 768) SSD_LD1(pc3, 3, 768)  \
    px = (xj < nvalid) ? gld16(XBC + (r0_ + xj) * 1024 + hh * 64 + ps * 32 + xq) : z4;   \
    if (tid < 64) pdt = (tid < nvalid) ? SC[(r0_ + tid) * 16 + hh] : 0.f;                \
  }
#define LDS_ST136(base, m_, v_) { const int idx_ = tid + 256 * (m_); *(uint4*)((base) + (idx_ >> 4) * 136 + (idx_ & 15) * 8) = (v_); }
  SSD_LOAD(0)
  for (int c = 0; c < nchunks; ++c) {
    const size_t row0 = (size_t)tok0 + (size_t)c * 64;
    LDS_ST136(Bm, 0, pb0) LDS_ST136(Bm, 1, pb1) LDS_ST136(Bm, 2, pb2) LDS_ST136(Bm, 3, pb3)
    LDS_ST136(Cm, 0, pc0) LDS_ST136(Cm, 1, pc1) LDS_ST136(Cm, 2, pc2) LDS_ST136(Cm, 3, pc3)
    if (tid < 64) { dtv[tid] = pdt; cum[tid] = wave_scan(pdt * a, lane); }
    const uint4 xc = px;
    __syncthreads();
    const float last = cum[63];
    {
      const float dtj = dtv[xj], w = __expf(last - cum[xj]);
      const unsigned xw[4] = {xc.x, xc.y, xc.z, xc.w};
#pragma unroll
      for (int e = 0; e < 8; ++e) {
        const float x = __uint_as_float((e & 1) ? (xw[e >> 1] & 0xffff0000u) : (xw[e >> 1] << 16)) * dtj;
        XT[(xq + e) * 72 + xj] = f2bf(x);
        XW[(xq + e) * 72 + xj] = f2bf(x * w);
      }
    }
    if (c + 1 < nchunks) SSD_LOAD(c + 1)
    {
      const int mi = wave >> 1, ni = wave & 1;
      f32x16 acc = zero16();
      mma_tile(acc, Cm + mi * 32 * 136, 136, Bm + ni * 32 * 136, 136, 128, lane);
      const int j = ni * 32 + (lane & 31);
      const float cj = cum[j];
      float ci[16];
#pragma unroll
      for (int r = 0; r < 16; ++r) ci[r] = cum[mi * 32 + TROW(r, lane)];
#pragma unroll
      for (int r = 0; r < 16; ++r) {
        const int i = mi * 32 + TROW(r, lane);
        G[i * 72 + j] = f2bf(j <= i ? acc[r] * __expf(ci[r] - cj) : 0.f);
      }
    }
    __syncthreads();
    if (wave < 2) {
      const int mi = wave;
      f32x16 acc1 = zero16(), acc2 = zero16();
      mma_tile(acc1, G + mi * 32 * 72, 72, XT, 72, 64, lane);
      mma_tile(acc2, Cm + mi * 32 * 136, 136, SB, 136, 128, lane);
      const int pr = lane & 31;
#pragma unroll
      for (int r = 0; r < 16; ++r) {
        const int i = mi * 32 + TROW(r, lane);
        if (i < nvalid) YS[(row0 + i) * 512 + hh * 64 + ps * 32 + pr] = acc1[r] + __expf(cum[i]) * acc2[r];
      }
    }
    {
      const float el = __expf(last);
#pragma unroll
      for (int r = 0; r < 16; ++r) accS[r] *= el;
      mma_tile_bg(accS, XW, 72, Bm + wave * 32, 136, 64, lane);
    }
    __syncthreads();
    {
      const int n = wave * 32 + (lane & 31);
#pragma unroll
      for (int r = 0; r < 16; ++r) SB[TROW(r, lane) * 136 + n] = f2bf(accS[r]);
    }
  }
#undef SSD_LOAD
#undef SSD_LD1
  {
    const int n = wave * 32 + (lane & 31);
#pragma unroll
    for (int r = 0; r < 16; ++r) sout[(size_t)(ps * 32 + TROW(r, lane)) * 128 + n] = accS[r];
  }
}

__device__ __forceinline__ void gdn_prep_unit(const Params& p, int u, char* smem) {
  const int tid = opaque_tid(), lane = tid & 63, wave = tid >> 6;
  int h, nvalid;
  size_t row0;
  if (u < 1024) { const int chain = u >> 5; h = chain & 3; row0 = (size_t)(chain >> 2) * 2048 + (size_t)(u & 31) * 64; nvalid = 64; }
  else { const int j2 = u - 1024; h = j2 & 3; row0 = (size_t)T_P + (j2 >> 2); nvalid = 1; }
  const gu16* QKV = (const gu16*)(p.ws() + WS_QKV);
  const gf32* SC = (const gf32*)(p.ws() + WS_SC);
  gu16* Aws = (gu16*)(p.ws() + WS_R1 + R1_AWS) + (size_t)u * 4096;
  gu16* ATTws = (gu16*)(p.ws() + WS_R1 + R1_ATT) + (size_t)u * 4096;
  u16* Kn = (u16*)smem;
  u16* Qn = Kn + 64 * 136;
  float* Mf = (float*)(Qn + 64 * 136);
  float* Xs = Mf + 64 * 68;
  float* cum = Xs + 64 * 64;
  float* beta = cum + 64;
  __syncthreads();
  stage_rows128(Qn, QKV + row0 * 1536 + h * 128, 1536, nvalid, tid);
  stage_rows128(Kn, QKV + row0 * 1536 + 512 + h * 128, 1536, nvalid, tid);
  if (tid < 64) {
    const bool ok = tid < nvalid;
    beta[tid] = ok ? SC[(row0 + tid) * 16 + 8 + h] : 0.f;
    cum[tid] = wave_scan(ok ? SC[(row0 + tid) * 16 + 12 + h] : 0.f, lane);
  }
  __syncthreads();
  {
    const int mi = wave >> 1, ni = wave & 1;
    f32x16 acc = zero16();
    mma_tile(acc, Kn + mi * 32 * 136, 136, Kn + ni * 32 * 136, 136, 128, lane);
    f32x16 acq = zero16();
    mma_tile(acq, Qn + mi * 32 * 136, 136, Kn + ni * 32 * 136, 136, 128, lane);
    const int j = ni * 32 + (lane & 31);
    const float cj = cum[j];
    float ci[16], bi[16];
#pragma unroll
    for (int r = 0; r < 16; ++r) { const int i = mi * 32 + TROW(r, lane); ci[r] = cum[i]; bi[r] = beta[i]; }
#pragma unroll
    for (int r = 0; r < 16; ++r) {
      const int i = mi * 32 + TROW(r, lane);
      const float dec = __expf(ci[r] - cj);
      Mf[j * 68 + i] = (j < i) ? bi[r] * acc[r] * dec : 0.f;
      ATTws[i * 64 + j] = f2bf(j <= i ? acq[r] * dec : 0.f);
    }
  }
  __syncthreads();
  if (wave == 0) {
    if (nvalid == 64) {
#pragma unroll 1
      for (int rb = 0; rb < 4; ++rb) {
        float s[16];
#pragma unroll
        for (int r = 0; r < 16; ++r) s[r] = (rb * 16 + r == lane) ? 1.f : 0.f;
#pragma unroll 2
        for (int j = 0; j < rb * 16; ++j) {
          const float xj = Xs[j * 64 + lane];
          const float4* mp = (const float4*)(Mf + j * 68 + rb * 16);
          const float4 m0 = mp[0], m1 = mp[1], m2 = mp[2], m3 = mp[3];
          s[0] -= m0.x * xj; s[1] -= m0.y * xj; s[2] -= m0.z * xj; s[3] -= m0.w * xj;
          s[4] -= m1.x * xj; s[5] -= m1.y * xj; s[6] -= m1.z * xj; s[7] -= m1.w * xj;
          s[8] -= m2.x * xj; s[9] -= m2.y * xj; s[10] -= m2.z * xj; s[11] -= m2.w * xj;
          s[12] -= m3.x * xj; s[13] -= m3.y * xj; s[14] -= m3.z * xj; s[15] -= m3.w * xj;
        }
#pragma unroll
        for (int q = 0; q < 16; ++q) {
          const float xq = s[q];
          Xs[(rb * 16 + q) * 64 + lane] = xq;
          Aws[(rb * 16 + q) * 64 + lane] = f2bf(xq);
#pragma unroll
          for (int r = q + 1; r < 16; ++r) s[r] -= Mf[(rb * 16 + q) * 68 + rb * 16 + r] * xq;
        }
      }
    } else {
#pragma unroll 8
      for (int i = 0; i < 64; ++i) Aws[i * 64 + lane] = (i == lane) ? (u16)0x3F80 : (u16)0;
    }
  }
}

__device__ __forceinline__ void gdn_unit(const Params& p, int job, char* smem) {
  const int tid = opaque_tid(), lane = tid & 63, wave = tid >> 6;
  int tok0, nchunks, nvalid, h, vs, ubase;
  const gf32* s0;
  gf32* sout;
  if (job < 128) {
    const int chain = job >> 2;
    vs = job & 3; h = chain & 3;
    tok0 = (chain >> 2) * 2048; nchunks = 32; nvalid = 64; s0 = nullptr; ubase = chain * 32;
    sout = p.out() + O_PGDN + (size_t)chain * 16384;
  } else {
    const int j2 = job - 128, chain = j2 >> 2;
    vs = j2 & 3; h = chain & 3;
    tok0 = T_P + (chain >> 2); nchunks = 1; nvalid = 1; ubase = 1024 + chain;
    s0 = p.in(I_ST_GDN) + (size_t)chain * 16384;
    sout = p.out() + O_SGDN + (size_t)chain * 16384;
  }
  const gu16* QKV = (const gu16*)(p.ws() + WS_QKV);
  const gf32* SC = (const gf32*)(p.ws() + WS_SC);
  const gu16* AWS = (const gu16*)(p.ws() + WS_R1 + R1_AWS);
  const gu16* ATW = (const gu16*)(p.ws() + WS_R1 + R1_ATT);
  gf32* OGD = (gf32*)(p.ws() + WS_R1 + R1_OGD);
  u16* Kn = (u16*)smem;
  u16* Qn = Kn + 64 * 136;
  u16* ST = Qn + 64 * 136;
  u16* Am = ST + 32 * 136;
  u16* ATT = Am + 64 * 72;
  u16* rhsT = ATT + 64 * 72;
  u16* uT = rhsT + 32 * 72;
  u16* uwT = uT + 32 * 72;
  float* cum = (float*)(uwT + 32 * 72);
  float* beta = cum + 64;
  __syncthreads();
  f32x16 accS = zero16();
  {
    const int k = wave * 32 + (lane & 31);
#pragma unroll
    for (int r = 0; r < 16; ++r) {
      const int v = TROW(r, lane);
      if (s0) accS[r] = s0[(size_t)k * 128 + vs * 32 + v];
      ST[v * 136 + k] = f2bf(accS[r]);
    }
  }
  const int vj = tid >> 2, vq = (tid & 3) * 8;
  uint4 pq0, pq1, pq2, pq3, pk0, pk1, pk2, pk3, pa0, pa1, pt0, pt1, pv;
  float pbeta = 0.f, pg = 0.f;
  const uint4 z4 = make_uint4(0, 0, 0, 0);
#define GDN_LD1(dst, m_, off_) { const int idx_ = tid + 256 * (m_); const int i_ = idx_ >> 4; \
    dst = (i_ < nvalid) ? gld16(QKV + (r0_ + i_) * 1536 + (off_) + h * 128 + (idx_ & 15) * 8) : z4; }
#define GDN_LOAD(c_)                                                                     \
  {                                                                                      \
    const size_t r0_ = (size_t)tok0 + (size_t)(c_) * 64;                                 \
    const size_t u_ = (size_t)ubase + (c_);                                              \
    GDN_LD1(pq0, 0, 0) GDN_LD1(pq1, 1, 0) GDN_LD1(pq2, 2, 0) GDN_LD1(pq3, 3, 0)          \
    GDN_LD1(pk0, 0, 512) GDN_LD1(pk1, 1, 512) GDN_LD1(pk2, 2, 512) GDN_LD1(pk3, 3, 512)  \
    pa0 = gld16(AWS + u_ * 4096 + (size_t)tid * 8); pa1 = gld16(AWS + u_ * 4096 + (size_t)(tid + 256) * 8); \
    pt0 = gld16(ATW + u_ * 4096 + (size_t)tid * 8); pt1 = gld16(ATW + u_ * 4096 + (size_t)(tid + 256) * 8); \
    pv = (vj < nvalid) ? gld16(QKV + (r0_ + vj) * 1536 + 1024 + h * 128 + vs * 32 + vq) : z4; \
    if (tid < 64) {                                                                      \
      const bool ok_ = tid < nvalid;                                                     \
      pbeta = ok_ ? SC[(r0_ + tid) * 16 + 8 + h] : 0.f;                                  \
      pg = ok_ ? SC[(r0_ + tid) * 16 + 12 + h] : 0.f;                                    \
    }                                                                                    \
  }
#define LDS_ST72(base, m_, v_) { const int idx_ = tid + 256 * (m_); *(uint4*)((base) + (idx_ >> 3) * 72 + (idx_ & 7) * 8) = (v_); }
  GDN_LOAD(0)
  for (int c = 0; c < nchunks; ++c) {
    const size_t row0 = (size_t)tok0 + (size_t)c * 64;
    __syncthreads();
    LDS_ST136(Qn, 0, pq0) LDS_ST136(Qn, 1, pq1) LDS_ST136(Qn, 2, pq2) LDS_ST136(Qn, 3, pq3)
    LDS_ST136(Kn, 0, pk0) LDS_ST136(Kn, 1, pk1) LDS_ST136(Kn, 2, pk2) LDS_ST136(Kn, 3, pk3)
    LDS_ST72(Am, 0, pa0) LDS_ST72(Am, 1, pa1) LDS_ST72(ATT, 0, pt0) LDS_ST72(ATT, 1, pt1)
    rhsT[(vq + 0) * 72 + vj] = (u16)(pv.x & 0xffffu); rhsT[(vq + 1) * 72 + vj] = (u16)(pv.x >> 16);
    rhsT[(vq + 2) * 72 + vj] = (u16)(pv.y & 0xffffu); rhsT[(vq + 3) * 72 + vj] = (u16)(pv.y >> 16);
    rhsT[(vq + 4) * 72 + vj] = (u16)(pv.z & 0xffffu); rhsT[(vq + 5) * 72 + vj] = (u16)(pv.z >> 16);
    rhsT[(vq + 6) * 72 + vj] = (u16)(pv.w & 0xffffu); rhsT[(vq + 7) * 72 + vj] = (u16)(pv.w >> 16);
    if (tid < 64) { beta[tid] = pbeta; cum[tid] = wave_scan(pg, lane); }
    __syncthreads();
    if (c + 1 < nchunks) GDN_LOAD(c + 1)
    const float last = cum[63];
    f32x16 accQ = zero16();
    if (wave < 2) {
      const int mi = wave;
      f32x16 acc = zero16();
      mma_tile(acc, Kn + mi * 32 * 136, 136, ST, 136, 128, lane);
      const int v = lane & 31;
      float vv[16], bj[16], cj[16];
#pragma unroll
      for (int r = 0; r < 16; ++r) {
        const int j = mi * 32 + TROW(r, lane);
        vv[r] = bf2f(rhsT[v * 72 + j]); bj[r] = beta[j]; cj[r] = cum[j];
      }
#pragma unroll
      for (int r = 0; r < 16; ++r) {
        const int j = mi * 32 + TROW(r, lane);
        rhsT[v * 72 + j] = f2bf(bj[r] * (vv[r] - __expf(cj[r]) * acc[r]));
      }
    } else {
      mma_tile(accQ, Qn + (wave - 2) * 32 * 136, 136, ST, 136, 128, lane);
    }
    __syncthreads();
    if (wave < 2) {
      const int mi = wave;
      f32x16 acc = zero16();
      mma_tile(acc, Am + mi * 32 * 72, 72, rhsT, 72, 64, lane);
      const int v = lane & 31;
      float ci[16];
#pragma unroll
      for (int r = 0; r < 16; ++r) ci[r] = cum[mi * 32 + TROW(r, lane)];
#pragma unroll
      for (int r = 0; r < 16; ++r) {
        const int i = mi * 32 + TROW(r, lane);
        uT[v * 72 + i] = f2bf(acc[r]);
        uwT[v * 72 + i] = f2bf(acc[r] * __expf(last - ci[r]));
      }
    }
    __syncthreads();
    if (wave >= 2) {
      const int mi = wave - 2;
      f32x16 acc = zero16();
      mma_tile(acc, ATT + mi * 32 * 72, 72, uT, 72, 64, lane);
      const int v = lane & 31;
#pragma unroll
      for (int r = 0; r < 16; ++r) {
        const int i = mi * 32 + TROW(r, lane);
        if (i < nvalid) OGD[(row0 + i) * 512 + h * 128 + vs * 32 + v] = acc[r] + __expf(cum[i]) * accQ[r];
      }
    }
    {
      const float el = __expf(last);
#pragma unroll
      for (int r = 0; r < 16; ++r) accS[r] *= el;
      mma_tile_bg(accS, uwT, 72, Kn + wave * 32, 136, 64, lane);
      const int k = wave * 32 + (lane & 31);
#pragma unroll
      for (int r = 0; r < 16; ++r) ST[TROW(r, lane) * 136 + k] = f2bf(accS[r]);
    }
  }
#undef GDN_LOAD
#undef GDN_LD1
  {
    const int k = wave * 32 + (lane & 31);
#pragma unroll
    for (int r = 0; r < 16; ++r) sout[(size_t)k * 128 + vs * 32 + TROW(r, lane)] = accS[r];
  }
}

__device__ __forceinline__ void postab_phase(const Params& p) {
  const int tid = opaque_tid(), lane = tid & 63;
  const int wg = blockIdx.x * 4 + (tid >> 6), nw = gridDim.x * 4;
  const gu16* Pab = (const gu16*)(p.ws() + WS_R1 + R1_PAB);
  const gf32* OG = (const gf32*)(p.ws() + WS_R1 + R1_OG);
  gu16* C0 = (gu16*)(p.ws() + WS_HC);
  float4 gg[2];
#pragma unroll
  for (int m = 0; m < 2; ++m) gg[m] = gldf4(p.in(I_G_GLA_NORM) + ((m * 256 + lane * 4) & 127));
  for (int row0 = wg; row0 < T_ALL; row0 += 2 * nw) {
    float4 o[2][2], r[2][2];
    bool ok[2];
#pragma unroll
    for (int u = 0; u < 2; ++u) {
      const int row = row0 + u * nw;
      ok[u] = row < T_ALL;
#pragma unroll
      for (int m = 0; m < 2; ++m) {
        const int c = m * 256 + lane * 4;
        if (ok[u]) { o[u][m] = gldf4(OG + (size_t)row * 512 + c); r[u][m] = ld_bf4(Pab + (size_t)row * N_AB + 1024 + c); }
        else { o[u][m] = make_float4(0.f, 0.f, 0.f, 0.f); r[u][m] = o[u][m]; }
      }
    }
#pragma unroll
    for (int u = 0; u < 2; ++u) {
      const int row = row0 + u * nw;
#pragma unroll
      for (int m = 0; m < 2; ++m) {
        const int c = m * 256 + lane * 4;
        const float4 ov = o[u][m], rv = r[u][m];
        const float ss = half_sum(ov.x * ov.x + ov.y * ov.y + ov.z * ov.z + ov.w * ov.w);
        const float rstd = rsqrtf(ss * (1.f / 128.f) + 1e-6f);
        if (ok[u])
          st_bf4(C0 + (size_t)row * 1024 + c, ov.x * rstd * gg[m].x * siluf_(rv.x), ov.y * rstd * gg[m].y * siluf_(rv.y),
                 ov.z * rstd * gg[m].z * siluf_(rv.z), ov.w * rstd * gg[m].w * siluf_(rv.w));
      }
    }
  }
}

__device__ __forceinline__ float cd_scalar(const Params& p, const gu16* PZG, size_t row, int sc) {
  const float raw = bf2f(PZG[row * 1040 + 1024 + sc]);
  if (sc < 8) return softplusf_(raw + p.in(I_SSD_DT_BIAS)[sc]);
  if (sc < 12) return sigmoidf_(raw);
  return -expf(p.in(I_GDN_A_LOG)[sc - 12]) * softplusf_(raw + p.in(I_GDN_DT_BIAS)[sc - 12]);
}
__device__ __forceinline__ void precd_phase(const Params& p) {
  const int tid = opaque_tid(), lane = tid & 63;
  const int wg = blockIdx.x * 4 + (tid >> 6), nw = gridDim.x * 4;
  const gu16* PX = (const gu16*)(p.ws() + WS_R1 + R1_PX);
  const gu16* PZG = (const gu16*)(p.ws() + WS_R1 + R1_PZG);
  gu16* XBC = (gu16*)(p.ws() + WS_HC);
  gu16* QKV = (gu16*)(p.ws() + WS_QKV);
  gf32* SC = (gf32*)(p.ws() + WS_SC);
  constexpr int NPU = 8 * 64 * 11, NSU = 128 * 10 + 1;
  for (int unit = wg; unit < NPU + NSU; unit += nw) {
    if (unit < NPU) {
      const int m = unit % 11, rr = unit / 11, t0 = (rr & 63) * 32, b = rr >> 6;
      const size_t rowbase = (size_t)b * 2048;
      if (m == 10) {
#pragma unroll
        for (int k = 0; k < 8; ++k) {
          const int v = lane + 64 * k;
          const size_t row = rowbase + t0 + (v >> 4);
          SC[row * 16 + (v & 15)] = cd_scalar(p, PZG, row, v & 15);
        }
      } else {
        const int cc = m * 256 + lane * 4;
        const bool isx = m < 4;
        const int cw = isx ? cc : cc - 1024;
        const int CW = isx ? 1024 : 1536;
        const gf32* wt = isx ? p.in(I_SSD_CONV_W) : p.in(I_GDN_CONV_W);
        const float4 w0 = gldf4(wt + cw), w1 = gldf4(wt + CW + cw), w2 = gldf4(wt + 2 * CW + cw), w3 = gldf4(wt + 3 * CW + cw);
        float4 bb = make_float4(0.f, 0.f, 0.f, 0.f);
        if (isx) bb = gldf4(p.in(I_SSD_CONV_B) + cw);
        const float4 zz = make_float4(0.f, 0.f, 0.f, 0.f);
        float4 x0 = zz, x1 = zz, x2 = zz;
        if (t0 > 0) {
          x0 = ld_bf4(PX + (rowbase + t0 - 3) * 2560 + cc);
          x1 = ld_bf4(PX + (rowbase + t0 - 2) * 2560 + cc);
          x2 = ld_bf4(PX + (rowbase + t0 - 1) * 2560 + cc);
        }
        const float qsc = (m < 6) ? 0.08838834764831845f : 1.f;
        gf32* cso = p.out() + (isx ? O_PSSDC : O_PGDNC) + (size_t)b * 3 * CW + cw;
#pragma unroll 1
        for (int tb = t0; tb < t0 + 32; tb += 16) {
          float4 xs[16];
#pragma unroll
          for (int u = 0; u < 16; ++u) xs[u] = ld_bf4(PX + (rowbase + tb + u) * 2560 + cc);
#pragma unroll
          for (int u = 0; u < 16; ++u) {
            const int t = tb + u;
            const size_t row = rowbase + t;
            const float4 x3 = xs[u];
            const float a0 = x0.x * w0.x + x1.x * w1.x + x2.x * w2.x + x3.x * w3.x + bb.x;
            const float a1 = x0.y * w0.y + x1.y * w1.y + x2.y * w2.y + x3.y * w3.y + bb.y;
            const float a2 = x0.z * w0.z + x1.z * w1.z + x2.z * w2.z + x3.z * w3.z + bb.z;
            const float a3 = x0.w * w0.w + x1.w * w1.w + x2.w * w2.w + x3.w * w3.w + bb.w;
            float v0 = siluf_(a0), v1 = siluf_(a1), v2 = siluf_(a2), v3 = siluf_(a3);
            if (isx) {
              st_bf4(XBC + row * 1024 + cc, v0, v1, v2, v3);
            } else {
              if (m < 8) {
                const float ss = half_sum(v0 * v0 + v1 * v1 + v2 * v2 + v3 * v3);
                const float sc = rsqrtf(ss + 1e-6f) * qsc;
                v0 *= sc; v1 *= sc; v2 *= sc; v3 *= sc;
              }
              st_bf4(QKV + row * 1536 + cw, v0, v1, v2, v3);
            }
            if (t >= 2045) gstf4(cso + (size_t)(t - 2045) * CW, x3);
            x0 = x1; x1 = x2; x2 = x3;
          }
        }
      }
    } else {
      const int su = unit - NPU;
      if (su == 1280) {
#pragma unroll 4
        for (int k = 0; k < 32; ++k) {
          const int v = lane + 64 * k;
          const size_t row = (size_t)T_P + (v >> 4);
          SC[row * 16 + (v & 15)] = cd_scalar(p, PZG, row, v & 15);
        }
      } else {
        const int s = su / 10, m = su % 10;
        const size_t row = (size_t)T_P + s;
        const int cc = m * 256 + lane * 4;
        const bool isx = m < 4;
        const int cw = isx ? cc : cc - 1024;
        const int CW = isx ? 1024 : 1536;
        const gf32* wt = isx ? p.in(I_SSD_CONV_W) : p.in(I_GDN_CONV_W);
        const gf32* sb = (isx ? p.in(I_ST_SSDC) : p.in(I_ST_GDNC)) + (size_t)s * 3 * CW + cw;
        gf32* so = p.out() + (isx ? O_SSSDC : O_SGDNC) + (size_t)s * 3 * CW + cw;
        const float4 x0 = gldf4(sb), x1 = gldf4(sb + CW), x2 = gldf4(sb + 2 * CW);
        const float4 x3 = ld_bf4(PX + row * 2560 + cc);
        const float4 w0 = gldf4(wt + cw), w1 = gldf4(wt + CW + cw), w2 = gldf4(wt + 2 * CW + cw), w3 = gldf4(wt + 3 * CW + cw);
        float4 bb = make_float4(0.f, 0.f, 0.f, 0.f);
        if (isx) bb = gldf4(p.in(I_SSD_CONV_B) + cw);
        gstf4(so, x1); gstf4(so + CW, x2); gstf4(so + 2 * CW, x3);
        const float a0 = x0.x * w0.x + x1.x * w1.x + x2.x * w2.x + x3.x * w3.x + bb.x;
        const float a1 = x0.y * w0.y + x1.y * w1.y + x2.y * w2.y + x3.y * w3.y + bb.y;
        const float a2 = x0.z * w0.z + x1.z * w1.z + x2.z * w2.z + x3.z * w3.z + bb.z;
        const float a3 = x0.w * w0.w + x1.w * w1.w + x2.w * w2.w + x3.w * w3.w + bb.w;
        float v0 = siluf_(a0), v1 = siluf_(a1), v2 = siluf_(a2), v3 = siluf_(a3);
        if (isx) {
          st_bf4(XBC + row * 1024 + cc, v0, v1, v2, v3);
        } else {
          if (m < 8) {
            const float ss = half_sum(v0 * v0 + v1 * v1 + v2 * v2 + v3 * v3);
            const float sc = rsqrtf(ss + 1e-6f) * ((m < 6) ? 0.08838834764831845f : 1.f);
            v0 *= sc; v1 *= sc; v2 *= sc; v3 *= sc;
          }
          st_bf4(QKV + row * 1536 + cw, v0, v1, v2, v3);
        }
      }
    }
  }
}

__device__ __forceinline__ void postcd_phase(const Params& p) {
  const int tid = opaque_tid(), lane = tid & 63;
  const int wg = blockIdx.x * 4 + (tid >> 6), nw = gridDim.x * 4;
  const gu16* PZG = (const gu16*)(p.ws() + WS_R1 + R1_PZG);
  const gf32* YS = (const gf32*)(p.ws() + WS_R1 + R1_YS);
  const gf32* OGD = (const gf32*)(p.ws() + WS_R1 + R1_OGD);
  gu16* HC = (gu16*)(p.ws() + WS_HC);
  for (int row = wg; row < T_ALL; row += nw) {
    float4 val[4];
#pragma unroll
    for (int m = 0; m < 2; ++m) {
      const int c = m * 256 + lane * 4;
      const float4 y = gldf4(YS + (size_t)row * 512 + c);
      const float4 xs = ld_bf4(HC + (size_t)row * 1024 + c);
      const float4 z = ld_bf4(PZG + (size_t)row * 1040 + c);
      const float dd = p.in(I_SSD_D)[c >> 6];
      float4 v = make_float4((y.x + dd * xs.x) * siluf_(z.x), (y.y + dd * xs.y) * siluf_(z.y),
                             (y.z + dd * xs.z) * siluf_(z.z), (y.w + dd * xs.w) * siluf_(z.w));
      const float ss = wave_sum(v.x * v.x + v.y * v.y + v.z * v.z + v.w * v.w);
      const float rstd = rsqrtf(ss * (1.f / 256.f) + 1e-6f);
      const float4 gg = gldf4(p.in(I_SSD_NORM) + c);
      val[m] = make_float4(v.x * rstd * gg.x, v.y * rstd * gg.y, v.z * rstd * gg.z, v.w * rstd * gg.w);
    }
#pragma unroll
    for (int m = 0; m < 2; ++m) {
      const int c = m * 256 + lane * 4;
      const float4 o = gldf4(OGD + (size_t)row * 512 + c);
      const float ss = half_sum(o.x * o.x + o.y * o.y + o.z * o.z + o.w * o.w);
      const float rstd = rsqrtf(ss * (1.f / 128.f) + 1e-6f);
      const float4 gg = gldf4(p.in(I_GDN_NORM) + (c & 127));
      const float4 gt = ld_bf4(PZG + (size_t)row * 1040 + 512 + c);
      val[2 + m] = make_float4(o.x * rstd * gg.x * siluf_(gt.x), o.y * rstd * gg.y * siluf_(gt.y),
                               o.z * rstd * gg.z * siluf_(gt.z), o.w * rstd * gg.w * siluf_(gt.w));
    }
#pragma unroll
    for (int m = 0; m < 4; ++m)
      st_bf4(HC + (size_t)row * 1024 + m * 256 + lane * 4, val[m].x, val[m].y, val[m].z, val[m].w);
  }
}


#define XB_TMO      128
#define XB_XCNT(j)  (256  + 64 * (j))
#define XB_XSUB(j)  (1280 + 64 * (j))
#define XB_XGEN(j)  (2304 + 64 * (j))
#define XB_TOP      3328
#define XB_TOPGEN   3392
#define XCD_BAR_WORDS 3456
#define XB_SPIN_CAP (1u << 18)
#define LAS __attribute__((address_space(3)))
__device__ __forceinline__ unsigned xb_ld(guint* p) { return __hip_atomic_load(p, __ATOMIC_RELAXED, __HIP_MEMORY_SCOPE_AGENT); }
__device__ __forceinline__ unsigned xb_add(guint* p, unsigned v) { return __hip_atomic_fetch_add(p, v, __ATOMIC_RELAXED, __HIP_MEMORY_SCOPE_AGENT); }
__device__ __forceinline__ unsigned xb_xcc_id() { return (unsigned)__builtin_amdgcn_s_getreg((3 << 11) | 20) & 0xFu; }
#define XB_SPIN(cond, bar) do { unsigned _sp = 0; while (cond) { __builtin_amdgcn_s_sleep(1); \
    if ((++_sp & 255u) == 0u) { if (xb_ld(&(bar)[XB_TMO])) break; if (_sp > XB_SPIN_CAP) { (void)xb_add(&(bar)[XB_TMO], 1u); break; } } } } while (0)
struct XcdBarrier { guint* bar; unsigned x; volatile LAS unsigned* st; };
__device__ __forceinline__ XcdBarrier xcd_barrier_post(guint* bar, volatile LAS unsigned* st) {
  XcdBarrier b; b.bar = bar; b.x = xb_xcc_id(); b.st = st;
  if (threadIdx.x == 0) (void)xb_add(&bar[XB_XCNT(b.x)], 1u);
  return b;
}
__device__ __forceinline__ void xcd_barrier_complete(guint* bar, unsigned x, unsigned& nloc, unsigned& nx) {
  const unsigned G = gridDim.x * gridDim.y * gridDim.z;
  unsigned sum, cnt, mine, sp = 0u;
  for (;;) {
    sum = 0u; cnt = 0u; mine = 0u;
#pragma unroll
    for (unsigned j = 0; j < 16; ++j) { const unsigned c = xb_ld(&bar[XB_XCNT(j)]); sum += c; cnt += (c > 0u) ? 1u : 0u; mine = (j == x) ? c : mine; }
    if (sum == G) break;
    __builtin_amdgcn_s_sleep(1);
    if ((++sp & 255u) == 0u) { if (xb_ld(&bar[XB_TMO])) break; if (sp > XB_SPIN_CAP) { (void)xb_add(&bar[XB_TMO], 1u); break; } }
  }
  nloc = mine > 0u ? mine : 1u; nx = cnt > 0u ? cnt : 1u;
}
__device__ __forceinline__ void xcd_barrier(const XcdBarrier& b) {
  asm volatile("s_waitcnt vmcnt(0)" ::: "memory");
  __syncthreads();
  if (threadIdx.x == 0) {
    guint* bar = b.bar;
    __builtin_amdgcn_s_waitcnt(0);
    unsigned nloc = b.st[0], nx = b.st[1];
    if (nloc == 0u) { xcd_barrier_complete(bar, b.x, nloc, nx); b.st[0] = nloc; b.st[1] = nx; }
    const unsigned old = xb_add(&bar[XB_XSUB(b.x)], 1u);
    const unsigned gen = old / nloc;
    if (old + 1u == (gen + 1u) * nloc) {
      __builtin_amdgcn_fence(__ATOMIC_RELEASE, "agent");
      asm volatile("s_waitcnt vmcnt(0)" ::: "memory");
      const unsigned og = xb_add(&bar[XB_TOP], 1u);
      const unsigned tg = og / nx;
      if (og + 1u == (tg + 1u) * nx) xb_add(&bar[XB_TOPGEN], 1u);
      else XB_SPIN(xb_ld(&bar[XB_TOPGEN]) == tg, bar);
      __builtin_amdgcn_fence(__ATOMIC_ACQUIRE, "agent");
      xb_add(&bar[XB_XGEN(b.x)], 1u);
      asm volatile("s_waitcnt vmcnt(0)" ::: "memory");
    } else {
      XB_SPIN(xb_ld(&bar[XB_XGEN(b.x)]) == gen, bar);
      __builtin_amdgcn_fence(__ATOMIC_ACQUIRE, "agent");
      asm volatile("s_waitcnt vmcnt(0)" ::: "memory");
    }
  }
  __syncthreads();
}

constexpr int N_PHASES = 20;

template <int ph>
__device__ __forceinline__ void run_phase(const Params& p, char* smem) {
  gchar* W = p.ws() + WS_W;
  gu16* HC = (gu16*)(p.ws() + WS_HC);
  gchar* R1 = p.ws() + WS_R1;
  Epi e{};
  e.x0 = p.in(I_XP); e.x1 = p.in(I_XS); e.of = p.out();
  switch (ph) {
    case 0:
      convert_weight(p.in(I_W_IN_AB), 1024, 2064, (gu16*)(W + W_INAB), N_AB, 1, smem);
      norm_phase(p, 0, p.in(I_NORM_MIX), 0);
      break;
    case 1:
      e.ob = (gu16*)(R1 + R1_PAB);
      gemm_phase_xcd<EPI_INAB>(HC, 1024, (const gu16*)(W + W_INAB), 1024, N_AB / 128, e, smem);
      break;
    case 2:
      for (;;) {
        const int job = q_next(p, 0, smem);
        if (job >= 1856 + 1184) break;
        if (job >= 1856) { for (int t2 = 0; t2 < 2; ++t2) convert_filler(p, 0, (job - 1856) * 2 + t2, smem); }
        else if (job >= 256 && job < 1792) gla_prep_unit(p, job - 256, smem);
        else s5_unit(p, job < 256 ? job : job - 1536, smem);
      }
      break;
    case 3:
      e.ob = HC; e.yb = (const gu16*)(R1 + R1_YBF); e.bias = p.in(I_B_S5_GLU);
      for (;;) {
        const int job = q_next(p, 3, smem);
        if (job >= 2692) break;
        if (job >= 128 && job < 644) gemm_tile<EPI_GLU>((const gu16*)(R1 + R1_YBF), 512, (const gu16*)(W + W_GLU), 512, 4, e, smem, job - 128);
        else gla_seq_unit(p, job < 128 ? job : job - 516, smem);
      }
      break;
    case 4:
      postab_phase(p);
      break;
    case 5:
      gemm_res_phase<EPI_RES0>(HC, 1024, (const gu16*)(W + W_OUTAB), 1024, e, (gf32*)(p.ws() + WS_SLAB), smem);
      break;
    case 6:
      norm_phase(p, 1, p.in(I_NORM_MLP), 2);
      break;
    case 7:
      e.ob = (gu16*)R1;
      gemm_phase<EPI_UP>(HC, 1024, (const gu16*)(W + W_UP0), 1024, 32, e, smem);
      break;
    case 8:
      gemm_res_phase<EPI_RES>((const gu16*)R1, 4096, (const gu16*)(W + W_DOWN0), 4096, e, (gf32*)(p.ws() + WS_SLAB), smem);
      break;
    case 9:
      norm_phase(p, 1, p.in(I_NORM_MIX) + 1024, 1);
      convert_weight(p.in(I_W_IN_CD), 1024, 3600, (gu16*)(W + W_INCD), N_CD, 2, smem);
      break;
    case 10:
      e.ob = (gu16*)(R1 + R1_PX); e.ob2 = (gu16*)(R1 + R1_PZG);
      gemm_phase_xcd<EPI_INCD>(HC, 1024, (const gu16*)(W + W_INCD), 1024, N_CD / 128, e, smem);
      break;
    case 11:
      precd_phase(p);
      break;
    case 12:
      for (;;) {
        const int job = q_next(p, 1, smem);
        if (job >= 3584 + 1152) break;
        if (job >= 3584) { for (int t2 = 0; t2 < 2; ++t2) convert_filler(p, 1, (job - 3584) * 2 + t2, smem); }
        else if (job < 1536) gdn_prep_unit(p, job, smem);
        else ssd_unit(p, job - 1536 + 128, smem);
      }
      break;
    case 13:
      for (;;) {
        const int job = q_next(p, 2, smem);
        if (job >= 2304) break;
        if (job >= 128 && job < 256) ssd_unit(p, job - 128, smem);
        else gdn_unit(p, job < 128 ? job : job - 128, smem);
      }
      break;
    case 14:
      postcd_phase(p);
      break;
    case 15:
      gemm_res_phase<EPI_RES>(HC, 1024, (const gu16*)(W + W_OUTCD), 1024, e, (gf32*)(p.ws() + WS_SLAB), smem);
      break;
    case 16:
      norm_phase(p, 1, p.in(I_NORM_MLP) + 1024, 1);
      break;
    case 17:
      e.ob = (gu16*)R1;
      gemm_phase<EPI_UP>(HC, 1024, (const gu16*)(W + W_UP1), 1024, 32, e, smem);
      break;
    case 18:
      gemm_res_phase<EPI_RES>((const gu16*)R1, 4096, (const gu16*)(W + W_DOWN1), 4096, e, (gf32*)(p.ws() + WS_SLAB), smem);
      break;
    case 19:
      norm_phase(p, 2, p.in(I_NORM_FINAL), 1);
      break;
    default: break;
  }
}

__global__ void __launch_bounds__(256, 2) hybrid_fwd(Params p) {
  extern __shared__ __attribute__((aligned(16))) char smem[];
  cg::grid_group grid = cg::this_grid();
  Params* lp = (Params*)(smem + LP_OFF);
  volatile LAS unsigned* xst = (volatile LAS unsigned*)(smem + XB_ST_OFF);
  if (threadIdx.x == 0) { *lp = p; xst[0] = 0u; xst[1] = 0u; }
  __syncthreads();
  if (p.ph_lo < 0) grid.sync();
  XcdBarrier xb;
  xb.bar = (guint*)(p.ws() + WS_BAR); xb.x = 0; xb.st = xst;
  if (p.ph_hi - p.ph_lo > 1) xb = xcd_barrier_post((guint*)(p.ws() + WS_BAR), xst);
#define PHASE(n)                                   \
  if (p.ph_lo <= (n) && (n) < p.ph_hi) {           \
    run_phase<(n)>(*lp, smem);                     \
    if ((n) + 1 < p.ph_hi) xcd_barrier(xb);        \
  }
  PHASE(0) PHASE(1) PHASE(2) PHASE(3) PHASE(4) PHASE(5) PHASE(6) PHASE(7) PHASE(8) PHASE(9)
  PHASE(10) PHASE(11) PHASE(12) PHASE(13) PHASE(14) PHASE(15) PHASE(16) PHASE(17) PHASE(18) PHASE(19)
}

extern "C" void kernel_launch(void* const* d_in, const int* in_sizes, int n_in, void* d_out, int out_size, void* d_ws,
                              size_t ws_size, hipStream_t stream) {
  static int grid_blocks = 0;
  if (grid_blocks == 0) {
    if (n_in != N_INPUTS || (size_t)out_size != O_END || ws_size < WS_END) {
      fprintf(stderr, "kernel_launch: unexpected sizes n_in %d out %d ws %zu (need %zu)\n", n_in, out_size, ws_size,
              (size_t)WS_END);
      grid_blocks = -1;
      return;
    }
    int dev = 0, cus = 0, per_cu = 0;
    (void)hipGetDevice(&dev);
    (void)hipDeviceGetAttribute(&cus, hipDeviceAttributeMultiprocessorCount, dev);
    if (hipFuncSetAttribute((const void*)hybrid_fwd, hipFuncAttributeMaxDynamicSharedMemorySize, LDS_BYTES) != hipSuccess) {
      fprintf(stderr, "kernel_launch: hipFuncSetAttribute failed\n");
      grid_blocks = -1;
      return;
    }
    if (hipOccupancyMaxActiveBlocksPerMultiprocessor(&per_cu, (const void*)hybrid_fwd, 256, LDS_BYTES) != hipSuccess || per_cu < 1) {
      fprintf(stderr, "kernel_launch: occupancy query failed (%d)\n", per_cu);
      (void)hipGetLastError();
      per_cu = 1;
    }
    if (per_cu > 2) per_cu = 2;
    grid_blocks = cus * per_cu;
  }
  if (grid_blocks < 0) return;
  (void)hipMemsetAsync((char*)d_ws + WS_CTR, 0, 256 + 16384, stream);
  Params p{};
  for (int i = 0; i < N_INPUTS; ++i) p.in_[i] = (const float*)d_in[i];
  p.out_ = (float*)d_out;
  p.ws_ = (char*)d_ws;
#if MULTI_LAUNCH
  for (int ph = 0; ph < N_PHASES; ++ph) {
    p.ph_lo = ph; p.ph_hi = ph + 1;
    hipLaunchKernelGGL(hybrid_fwd, dim3(grid_blocks), dim3(256), LDS_BYTES, stream, p);
#ifdef PROBE_DUP
    if ((PROBE_DUP >> ph) & 1) {
      (void)hipMemsetAsync((char*)d_ws + WS_CTR, 0, 256, stream);
      hipLaunchKernelGGL(hybrid_fwd, dim3(grid_blocks), dim3(256), LDS_BYTES, stream, p);
    }
#endif
  }
#else
  p.ph_lo = 0; p.ph_hi = N_PHASES;
  void* args[] = {&p};
  hipError_t err = hipLaunchCooperativeKernel((const void*)hybrid_fwd, dim3(grid_blocks), dim3(256), args, LDS_BYTES, stream);
  if (err != hipSuccess) fprintf(stderr, "cooperative launch failed: %s (grid %d)\n", hipGetErrorString(err), grid_blocks);
#endif
}
```
